# Optimizing an MI355X kernel written in HIP

```python
import math
import jax
import jax.numpy as jnp
from jax import lax
import numpy as np

D_MODEL = 1024
BATCH = 16
SEQ = 2048
DEPTH = 2

GRID_W = 64
CTX_LEN = 256
EXPAND = 2
D_INNER = EXPAND * D_MODEL
A_HEADS = 8
A_HEAD_DIM = 64
A_V_DIM = 2 * A_HEAD_DIM
A_WIDTH = A_HEADS * A_V_DIM
POOL_WIDTH = D_INNER - A_WIDTH
POOL_WINDOWS = (2, 4, 8, 16)
POOL_GROUP = POOL_WIDTH // len(POOL_WINDOWS)
A_SPLITS = (A_WIDTH, 2 * A_WIDTH, 3 * A_WIDTH, 3 * A_WIDTH + POOL_WIDTH)
A_IN_COLS = 3 * A_WIDTH + POOL_WIDTH + D_INNER
Q_BLOCK = 128
ROPE_THETA = 10000.0
H_ORDER = 2
H_WIDTH = D_INNER
H_IN_COLS = (H_ORDER + 1) * H_WIDTH + D_INNER
SHORT_CONV = 3
FILTER_EMB = 33
FILTER_BANDS = (FILTER_EMB - 1) // 2
FILTER_HIDDEN = 64
DECAY_TARGET = 1e-2
FAST_DECAY_PCT = 0.3
SLOW_DECAY_PCT = 1.5
RMS_EPS = 1e-6
SUBLN_EPS = 1e-5
N_EVEN = (DEPTH + 1) // 2
N_ODD = DEPTH // 2

kernel_name = 'hybrid_diffattn_pool_hyena_block'


def rmsnorm(x, g, eps=RMS_EPS):
    xf = x.astype(jnp.float32)
    y = xf * lax.rsqrt(jnp.mean(xf * xf, axis=-1, keepdims=True) + eps)
    return (y * g.astype(jnp.float32)).astype(x.dtype)


def _ada(cond, w, b):
    return jnp.split(jax.nn.silu(cond) @ w + b, 3, axis=-1)


def _modulate(x, g, shift, scale):
    return rmsnorm(x, g) * (1 + scale) + shift


def _ctx_read_later(i):
    return any(j % 2 == 0 for j in range(i + 1, DEPTH))


def axial_rope_tables(rows, dtype):
    row = jnp.repeat(jnp.arange(rows), GRID_W).astype(jnp.float32)
    col = jnp.tile(jnp.arange(GRID_W), rows).astype(jnp.float32)
    half = A_HEAD_DIM // 2
    inv = ROPE_THETA ** (-jnp.arange(0, half, 2, dtype=jnp.float32) / half)
    ar, ac = row[:, None] * inv, col[:, None] * inv
    ang = jnp.concatenate([ar, ar, ac, ac], axis=-1)
    return jnp.cos(ang).astype(dtype), jnp.sin(ang).astype(dtype)


def apply_rope(t, cos, sin):
    r1, r2, c1, c2 = jnp.split(t, 4, axis=-1)
    rot = jnp.concatenate([-r2, r1, -c2, c1], axis=-1)
    return t * cos[:, None, :] + rot * sin[:, None, :]


def _split_heads_qk(t, cos=None, sin=None):
    b, n = t.shape[:2]
    t = t.reshape(b, n, 2 * A_HEADS, A_HEAD_DIM)
    if cos is not None:
        t = apply_rope(t, cos, sin)
    return t.reshape(b, n, A_HEADS, 2, A_HEAD_DIM)


def diff_attention(q, k, v, lam):
    s = jnp.einsum('bqhid,bkhid->bhiqk', q, k).astype(jnp.float32) * (A_HEAD_DIM ** -0.5)
    p = jax.nn.softmax(s, axis=-1)
    a = p[:, :, 0] - lam * p[:, :, 1]
    return jnp.einsum('bhqk,bkhe->bqhe', a.astype(v.dtype), v)


def blocked_diff_attention(q, k, v, lam):
    b, n = q.shape[:2]
    nb = n // Q_BLOCK
    qb = q.reshape(b, nb, Q_BLOCK, *q.shape[2:]).swapaxes(0, 1)
    ob = lax.map(lambda qi: diff_attention(qi, k, v, lam), qb)
    return ob.swapaxes(0, 1).reshape(b, n, *ob.shape[3:])


def multiscale_pool(p, pool_w, pool_scale):
    n = p.shape[1]
    pf = p.astype(jnp.float32)
    cs = jnp.concatenate([jnp.zeros_like(pf[:, :1]), jnp.cumsum(pf, axis=1)], axis=1)
    t = jnp.arange(n)
    outs = []
    for gi, win in enumerate(POOL_WINDOWS):
        lo = jnp.clip(t - win // 2, 0, n)
        hi = jnp.clip(t + win - win // 2, 0, n)
        sl = slice(gi * POOL_GROUP, (gi + 1) * POOL_GROUP)
        csg = cs[..., sl]
        mean = (csg[:, hi] - csg[:, lo]) / (hi - lo).astype(jnp.float32)[:, None]
        outs.append(mean - pf[..., sl])
    m = jnp.stack(outs, axis=2).astype(p.dtype)
    y = jnp.einsum('blgc,gcd->blgd', m, pool_w).reshape(p.shape)
    return y * pool_scale


def _diffpool_out(o, p, g, subln_g, pool_w, pool_scale, w_out, lam_init):
    o = rmsnorm(o, subln_g, SUBLN_EPS) * (1.0 - lam_init)
    o = o.reshape(*o.shape[:2], A_WIDTH)
    y = jnp.concatenate([o, multiscale_pool(p, pool_w, pool_scale)], axis=-1)
    return (y * jax.nn.silu(g)) @ w_out


def diffpool_layer(h_lat, h_ctx, cos, sin, w_in, lq1, lk1, lq2, lk2, subln_g, pool_w, pool_scale,
                   w_out, lam_init, update_ctx):
    f32 = jnp.float32
    lam = (jnp.exp(jnp.sum(lq1.astype(f32) * lk1.astype(f32)))
           - jnp.exp(jnp.sum(lq2.astype(f32) * lk2.astype(f32))) + lam_init)
    q, k, v, p, g = jnp.split(h_lat @ w_in, A_SPLITS, axis=-1)
    q = _split_heads_qk(q, cos, sin)
    k = _split_heads_qk(k, cos, sin)
    v = v.reshape(*v.shape[:2], A_HEADS, A_V_DIM)
    if update_ctx:
        q_c, k_c, v_c, p_c, g_c = jnp.split(h_ctx @ w_in, A_SPLITS, axis=-1)
    else:
        k_c, v_c = jnp.split(h_ctx @ w_in[:, A_WIDTH:3 * A_WIDTH], 2, axis=-1)
    k_c = _split_heads_qk(k_c)
    v_c = v_c.reshape(*v_c.shape[:2], A_HEADS, A_V_DIM)
    k_all = jnp.concatenate([k_c, k], axis=1)
    v_all = jnp.concatenate([v_c, v], axis=1)
    o = blocked_diff_attention(q, k_all, v_all, lam)
    y_lat = _diffpool_out(o, p, g, subln_g, pool_w, pool_scale, w_out, lam_init)
    y_ctx = None
    if update_ctx:
        o_c = diff_attention(_split_heads_qk(q_c), k_c, v_c, lam)
        y_ctx = _diffpool_out(o_c, p_c, g_c, subln_g, pool_w, pool_scale, w_out, lam_init)
    return y_lat, y_ctx


def short_conv(u, w, b):
    n = u.shape[1]
    pad = SHORT_CONV // 2
    up = jnp.pad(u, ((0, 0), (pad, SHORT_CONV - 1 - pad), (0, 0)))
    y = b
    for j in range(SHORT_CONV):
        y = y + up[:, j:j + n] * w[j]
    return y


def hyena_filters(n, w0, b0, f0, w1, b1, f1, w2, b2, f2, wout):
    f32 = jnp.float32
    t = jnp.linspace(0.0, 1.0, n, dtype=f32)[:, None]
    w = 2.0 * math.pi * jnp.arange(n, dtype=f32)[:, None] / n
    bands = jnp.linspace(1e-4, FILTER_BANDS - 1, FILTER_BANDS, dtype=f32)[None, :]
    z = jnp.concatenate([t, jnp.cos(bands * w), -jnp.sin(bands * w)], axis=-1)
    h = jnp.sin(f0.astype(f32) * (z @ w0.astype(f32) + b0.astype(f32)))
    h = jnp.sin(f1.astype(f32) * (h @ w1.astype(f32) + b1.astype(f32)))
    h = jnp.sin(f2.astype(f32) * (h @ w2.astype(f32) + b2.astype(f32)))
    h = (h @ wout.astype(f32)).reshape(n, H_ORDER, 2, H_WIDTH)
    max_decay = math.log(DECAY_TARGET) / FAST_DECAY_PCT
    min_decay = math.log(DECAY_TARGET) / SLOW_DECAY_PCT
    deltas = jnp.linspace(min_decay, max_decay, H_WIDTH, dtype=f32)
    decay = jnp.exp(-t * jnp.abs(deltas))
    h = h * decay[:, None, None, :]
    fwd, bwd = h[:, :, 0], h[:, :, 1]
    g = jnp.concatenate([fwd, jnp.zeros_like(fwd[:1]), bwd[1:][::-1]], axis=0)
    return jnp.fft.rfft(g, axis=0)


def long_conv(u, gf, bias):
    n = u.shape[1]
    uf32 = u.astype(jnp.float32)
    uf = jnp.fft.rfft(uf32, n=2 * n, axis=1)
    y = jnp.fft.irfft(uf * gf[None], n=2 * n, axis=1)[:, :n]
    return (y + uf32 * bias.astype(jnp.float32)).astype(u.dtype)


def hyena_mixer(h, w_in, conv_w, conv_b, w0, b0, f0, w1, b1, f1, w2, b2, f2, wout, fbias, w_out):
    proj = h @ w_in
    u = short_conv(proj[..., :(H_ORDER + 1) * H_WIDTH], conv_w, conv_b)
    gate = proj[..., (H_ORDER + 1) * H_WIDTH:]
    v, x1, x2 = jnp.split(u, H_ORDER + 1, axis=-1)
    gf = hyena_filters(h.shape[1], w0, b0, f0, w1, b1, f1, w2, b2, f2, wout)
    z = x1 * long_conv(v, gf[:, 0], fbias[0])
    z = x2 * long_conv(z, gf[:, 1], fbias[1])
    return (z * jax.nn.silu(gate)) @ w_out


def setup_inputs(seed: int = 0) -> dict:
    key = jax.random.key(seed)
    ks = iter(jax.random.split(key, 40))
    nrm = lambda shape, s: jax.random.normal(next(ks), shape, jnp.float32) * s
    D, E, FH = D_MODEL, D_INNER, FILTER_HIDDEN
    return {
        'x': nrm((BATCH, SEQ, D), 1.0),
        'c': nrm((BATCH, D), 1.0),
        'ctx': nrm((BATCH, CTX_LEN, D), 1.0),
        'c_ctx': nrm((D,), 1.0),
        'norm_g': 1.0 + nrm((DEPTH, D), 0.02),
        'ada_w': nrm((DEPTH, D, 3 * D), 0.2 * D ** -0.5),
        'ada_b': nrm((DEPTH, 3 * D), 0.02),
        'final_g': 1.0 + nrm((D,), 0.02),
        'a_w_in': nrm((N_EVEN, D, A_IN_COLS), D ** -0.5),
        'a_lam_q1': nrm((N_EVEN, A_HEAD_DIM), 0.1),
        'a_lam_k1': nrm((N_EVEN, A_HEAD_DIM), 0.1),
        'a_lam_q2': nrm((N_EVEN, A_HEAD_DIM), 0.1),
        'a_lam_k2': nrm((N_EVEN, A_HEAD_DIM), 0.1),
        'a_subln_g': 1.0 + nrm((N_EVEN, A_V_DIM), 0.02),
        'a_pool_w': nrm((N_EVEN, len(POOL_WINDOWS), POOL_GROUP, POOL_GROUP), POOL_GROUP ** -0.5),
        'a_pool_scale': 0.5 + nrm((N_EVEN, POOL_WIDTH), 0.05),
        'a_w_out': nrm((N_EVEN, E, D), E ** -0.5),
        'h_w_in': nrm((N_ODD, D, H_IN_COLS), D ** -0.5),
        'h_conv_w': nrm((N_ODD, SHORT_CONV, (H_ORDER + 1) * H_WIDTH), SHORT_CONV ** -0.5),
        'h_conv_b': nrm((N_ODD, (H_ORDER + 1) * H_WIDTH), 0.02),
        'h_filt_w0': nrm((N_ODD, FILTER_EMB, FH), FILTER_EMB ** -0.5),
        'h_filt_b0': nrm((N_ODD, FH), 0.1),
        'h_filt_f0': 1.0 + nrm((N_ODD, FH), 0.1),
        'h_filt_w1': nrm((N_ODD, FH, FH), FH ** -0.5),
        'h_filt_b1': nrm((N_ODD, FH), 0.1),
        'h_filt_f1': 1.0 + nrm((N_ODD, FH), 0.1),
        'h_filt_w2': nrm((N_ODD, FH, FH), FH ** -0.5),
        'h_filt_b2': nrm((N_ODD, FH), 0.1),
        'h_filt_f2': 1.0 + nrm((N_ODD, FH), 0.1),
        'h_filt_wout': nrm((N_ODD, FH, 2 * H_ORDER * H_WIDTH), 0.02),
        'h_filt_bias': nrm((N_ODD, H_ORDER, H_WIDTH), 0.5),
        'h_w_out': nrm((N_ODD, E, D), E ** -0.5),
    }


def reference(x, c, ctx, c_ctx, norm_g, ada_w, ada_b, final_g, a_w_in, a_lam_q1, a_lam_k1, a_lam_q2,
              a_lam_k2, a_subln_g, a_pool_w, a_pool_scale, a_w_out, h_w_in, h_conv_w, h_conv_b,
              h_filt_w0, h_filt_b0, h_filt_f0, h_filt_w1, h_filt_b1, h_filt_f1, h_filt_w2, h_filt_b2,
              h_filt_f2, h_filt_wout, h_filt_bias, h_w_out):
    n = x.shape[1]
    rows = n // GRID_W
    cos, sin = axial_rope_tables(rows, x.dtype)
    ctx_stream = ctx
    for i in range(DEPTH):
        even = (i % 2 == 0)
        update_ctx = _ctx_read_later(i)
        shift, scale, gate = _ada(c[:, None, :], ada_w[i], ada_b[i])
        h_lat = _modulate(x, norm_g[i], shift, scale)
        h_ctx = None
        if even or update_ctx:
            shift_c, scale_c, gate_c = _ada(c_ctx[None, :], ada_w[i], ada_b[i])
            h_ctx = _modulate(ctx_stream, norm_g[i], shift_c, scale_c)
        if even:
            e = i // 2
            y_lat, y_ctx = diffpool_layer(
                h_lat, h_ctx, cos, sin, a_w_in[e], a_lam_q1[e], a_lam_k1[e], a_lam_q2[e], a_lam_k2[e],
                a_subln_g[e], a_pool_w[e], a_pool_scale[e], a_w_out[e],
                0.8 - 0.6 * math.exp(-0.3 * i), update_ctx)
        else:
            o = i // 2
            hp = (h_w_in[o], h_conv_w[o], h_conv_b[o], h_filt_w0[o], h_filt_b0[o], h_filt_f0[o],
                  h_filt_w1[o], h_filt_b1[o], h_filt_f1[o], h_filt_w2[o], h_filt_b2[o], h_filt_f2[o],
                  h_filt_wout[o], h_filt_bias[o], h_w_out[o])
            y_lat = hyena_mixer(h_lat, *hp)
            y_ctx = hyena_mixer(h_ctx, *hp) if update_ctx else None
        x = x + gate * y_lat
        if update_ctx:
            ctx_stream = ctx_stream + gate_c * y_ctx
    return rmsnorm(x, final_g)
```

```cpp
#include <hip/hip_runtime.h>
#include <hip/hip_cooperative_groups.h>
#include <cstdio>
#include <cstdint>
namespace cg = cooperative_groups;

#define DI __device__ __forceinline__
#define LAS __attribute__((address_space(3)))
typedef unsigned short u16;
typedef short bf16x8 __attribute__((ext_vector_type(8)));
typedef float f32x4 __attribute__((ext_vector_type(4)));
typedef float f32x2 __attribute__((ext_vector_type(2)));
typedef float f32x16 __attribute__((ext_vector_type(16)));
typedef unsigned u32x4 __attribute__((ext_vector_type(4)));
typedef unsigned u32x2 __attribute__((ext_vector_type(2)));
typedef __bf16 bf16x2_t __attribute__((ext_vector_type(2)));

DI unsigned pk2(float lo, float hi) { bf16x2_t v = __builtin_convertvector((f32x2){lo, hi}, bf16x2_t); return __builtin_bit_cast(unsigned, v); }
DI float bflo(unsigned w) { return __uint_as_float(w << 16); }
DI float bfhi(unsigned w) { return __uint_as_float(w & 0xffff0000u); }
DI float bf1(u16 h) { return __uint_as_float(((unsigned)h) << 16); }
DI float silu_f(float v) { return v * __builtin_amdgcn_rcpf(1.f + __builtin_amdgcn_exp2f(-1.4426950408889634f * v)); }
template <int M> DI float swz_xor(float v) { return __int_as_float(__builtin_amdgcn_ds_swizzle(__float_as_int(v), 0x1f | (M << 10))); }
DI float wave_sum(float v) {
  v += swz_xor<1>(v); v += swz_xor<2>(v); v += swz_xor<4>(v); v += swz_xor<8>(v); v += swz_xor<16>(v);
  return __uint_as_float(__builtin_amdgcn_readlane(__float_as_uint(v), 0)) + __uint_as_float(__builtin_amdgcn_readlane(__float_as_uint(v), 32));
}
DI float bperm(int idx4, float v) { return __int_as_float(__builtin_amdgcn_ds_bpermute(idx4, __float_as_int(v))); }

DI int lane_id() { int l; asm volatile("v_mbcnt_lo_u32_b32 %0, -1, 0\n\tv_mbcnt_hi_u32_b32 %0, -1, %0" : "=v"(l)); return l; }
#define OTID(wv) ((wv) * 64 + lane_id())
DI void gsync(unsigned* bar, unsigned target, int wv) {
  __syncthreads();
  if (wv == 0 && lane_id() == 0) {
    __hip_atomic_fetch_add(bar, 1u, __ATOMIC_RELEASE, __HIP_MEMORY_SCOPE_AGENT);
    while (__hip_atomic_load(bar, __ATOMIC_RELAXED, __HIP_MEMORY_SCOPE_AGENT) < target) __builtin_amdgcn_s_sleep(2);
    __builtin_amdgcn_fence(__ATOMIC_ACQUIRE, "agent");
  }
  __syncthreads();
}
constexpr int NB = 16, SEQ = 2048, DM = 1024, NTOK = NB * SEQ, CTXL = 256, NCTX = NB * CTXL, KALL = SEQ + CTXL;
constexpr size_t MB = 1024 * 1024;
constexpr size_t WS_ROPE = 4096;
constexpr size_t WS_GATE = 16384;
constexpr size_t WS_KPART = 147456;
constexpr size_t WS_ADAP = 256 * 1024;
constexpr size_t WS_H3 = 4 * MB;
constexpr size_t WS_WA = 5 * MB;
constexpr size_t WS_WAO = 17 * MB;
constexpr size_t WS_PW = 21 * MB;
constexpr size_t WS_WH = 22 * MB;
constexpr size_t WS_WHO = 38 * MB;
constexpr size_t WS_F = 42 * MB;
constexpr size_t WS_H = 74 * MB;
constexpr size_t WS_L = 138 * MB;
constexpr size_t WS_HC = WS_L;
constexpr size_t WS_K = WS_L + 8 * MB;
constexpr size_t WS_VT = WS_K + 72 * MB;
constexpr size_t WS_G = WS_VT + 72 * MB;
constexpr size_t WS_UT = WS_L;
constexpr size_t WS_ZT = WS_L + 128 * MB;
constexpr size_t WS_Z = WS_H;
constexpr size_t WS_END = 418 * MB;

struct Params { const float* in[32]; float* out; unsigned char* ws; };
enum { I_X = 0, I_C, I_CTX, I_CCTX, I_NORMG, I_ADAW, I_ADAB, I_FINALG, I_AWIN, I_LQ1, I_LK1, I_LQ2, I_LK2, I_SUBLN, I_POOLW, I_POOLS, I_AWOUT,
       I_HWIN, I_CONVW, I_CONVB, I_FW0, I_FB0, I_FF0, I_FW1, I_FB1, I_FF1, I_FW2, I_FB2, I_FF2, I_FWOUT, I_FBIAS, I_HWOUT };

namespace pg8 {
constexpr int BM = 256, BK = 64, HALF = 128, HTB = HALF * BK * 2, STAGE_BYTES = 8 * HTB, NXCD = 8, WGM = 8;
DI int lds_byte(int r, int c) { const int st = (r >> 4) * 2 + (c >> 5), rr = r & 15, cc = c & 31, ob = rr * 64 + cc * 2; return st * 1024 + (ob ^ (((ob >> 9) & 1) << 5)); }
DI void stage_rc(int b, int& R, int& C) { const int st = b / 1024, sb = b % 1024, swz = sb ^ (((sb >> 9) & 1) << 5); R = (st >> 1) * 16 + swz / 64; C = (st & 1) * 32 + (swz % 64) / 2; }
DI int perm32(int rho) { const int n = rho >> 4, i = rho & 15; return 8 * (i >> 2) + 4 * n + (i & 3); }
struct Unit { int pm, pn; };
struct Gemm { const u16* A; const u16* Bt; int M, N, K, lda, ldb; };
struct StaticOrder {
  int nM, nN, nwg, G, c;
  DI void init(int M, int N, int G_, int c_) { nM = M / BM; nN = N / BM; nwg = nM * nN; G = G_; c = c_; }
  DI bool next(int i, Unit& u) const {
    const long L = (long)i * G + c; if (L >= nwg) return false;
    int wgid = (int)L; { const int q = nwg / NXCD, r = nwg % NXCD, xcd = wgid % NXCD, off = wgid / NXCD; wgid = (xcd < r ? xcd * (q + 1) : r * (q + 1) + (xcd - r) * q) + off; }
    const int nig = WGM * nN, gid = wgid / nig, fm = gid * WGM, gsz = (nM - fm) < WGM ? (nM - fm) : WGM;
    u.pm = fm + ((wgid % nig) % gsz); u.pn = (wgid % nig) / gsz; return true;
  }
};
template <class Epi>
DI void gemm_phase(LAS unsigned char* lds, const Gemm g, const StaticOrder& S, const Epi& E, int wv) {
  const int wid = wv, lane = lane_id(), tid = wid * 64 + lane, wr = wid >> 2, wc = wid & 3, fr = lane & 15, fq = lane >> 4;
  const int K = g.K, nt = K / BK;
  unsigned voffA[2], voffB[2];
#pragma unroll
  for (int i = 0; i < 2; ++i) { int R, C; stage_rc(tid * 16 + i * 8192, R, C); const int Rb = Epi::PERM ? ((R & ~31) + perm32(R & 31)) : R;
    voffA[i] = (unsigned)(R * g.lda + C) * 2u; voffB[i] = (unsigned)(Rb * g.ldb + C) * 2u; }
  const size_t kstep = (size_t)(BK * 2);
  const size_t hstepA = (size_t)HALF * g.lda * 2, hstepB = (size_t)HALF * g.ldb * 2;
  const size_t tstepA = 2 * hstepA, tstepB = 2 * hstepB;
  const unsigned ldsw = (unsigned)wid * 1024u;
  const int aoff = lds_byte(wr * 64 + fr, fq * 8), boff = lds_byte(wc * 32 + fr, fq * 8);
#define PG8_SA(b, h) (((b) * 2 + (h)) * HTB)
#define PG8_SB(b, h) ((4 + (b) * 2 + (h)) * HTB)
#define PG8_STAGE(bufoff, gbase, voff) do { _Pragma("unroll") for (int _i = 0; _i < 2; ++_i) \
    __builtin_amdgcn_global_load_lds((const unsigned*)((const char*)(gbase) + (voff)[_i]), (LAS unsigned*)(lds + (bufoff) + ldsw + _i * 8192), 16, 0, 0); } while (0)
#define PG8_LDA(dst, b, h) do { _Pragma("unroll") for (int m = 0; m < 4; ++m) _Pragma("unroll") for (int k = 0; k < 2; ++k) dst[m][k] = *(const LAS bf16x8*)(lds + PG8_SA(b, h) + aoff + m * 2048 + k * 1024); } while (0)
#define PG8_LDB(dst, b, h) do { _Pragma("unroll") for (int n = 0; n < 2; ++n) _Pragma("unroll") for (int k = 0; k < 2; ++k) dst[n][k] = *(const LAS bf16x8*)(lds + PG8_SB(b, h) + boff + n * 2048 + k * 1024); } while (0)
#define PG8_MMA(ai, bj, At, Bt) do { __builtin_amdgcn_s_setprio(1); _Pragma("unroll") for (int m = 0; m < 4; ++m) _Pragma("unroll") for (int n = 0; n < 2; ++n) _Pragma("unroll") for (int k = 0; k < 2; ++k) \
    acc[ai][bj][m][n] = __builtin_amdgcn_mfma_f32_16x16x32_bf16(Bt[n][k], At[m][k], acc[ai][bj][m][n], 0, 0, 0); __builtin_amdgcn_s_setprio(0); } while (0)
#define PG8_WAIT_V(n) asm volatile("s_waitcnt vmcnt(" #n ")" ::: "memory")
#define PG8_WAIT_L(n) asm volatile("s_waitcnt lgkmcnt(" #n ")" ::: "memory")
#define PG8_BAR __builtin_amdgcn_s_barrier()
#define PG8_SCHED __builtin_amdgcn_sched_barrier(0)
  Unit cur, nxt; int ui = 0;
  if (!S.next(0, cur)) return;
  f32x4 acc[2][2][4][2];
#pragma unroll
  for (int a = 0; a < 2; ++a)
#pragma unroll
    for (int b = 0; b < 2; ++b)
#pragma unroll
      for (int m = 0; m < 4; ++m)
#pragma unroll
        for (int n = 0; n < 2; ++n) acc[a][b][m][n] = (f32x4){0.f, 0.f, 0.f, 0.f};
  bf16x8 At[4][2], B0[2][2], B1[2][2];
  const char* cA = (const char*)g.A + (size_t)cur.pm * tstepA; const char* cB = (const char*)g.Bt + (size_t)cur.pn * tstepB;
  PG8_STAGE(PG8_SB(0, 0), cB, voffB); PG8_STAGE(PG8_SA(0, 0), cA, voffA); PG8_STAGE(PG8_SB(0, 1), cB + hstepB, voffB); PG8_STAGE(PG8_SA(0, 1), cA + hstepA, voffA);
  if (wr == 1) PG8_BAR;
  PG8_WAIT_V(4); PG8_BAR;
  PG8_STAGE(PG8_SB(1, 0), cB + kstep, voffB); PG8_STAGE(PG8_SA(1, 0), cA + kstep, voffA); PG8_STAGE(PG8_SB(1, 1), cB + hstepB + kstep, voffB);
  PG8_WAIT_V(6); PG8_BAR;
  for (;;) {
    const bool has_next = S.next(ui + 1, nxt);
    const char* nA = has_next ? (const char*)g.A + (size_t)nxt.pm * tstepA : cA; const char* nB = has_next ? (const char*)g.Bt + (size_t)nxt.pn * tstepB : cB;
    for (int t = 0; t < nt; t += 2) {
      const bool last = (t == nt - 2);
      const char* a1 = cA + (size_t)(t + 1) * kstep;
      const char* a2 = last ? nA : cA + (size_t)(t + 2) * kstep; const char* b2 = last ? nB : cB + (size_t)(t + 2) * kstep;
      const char* a3 = a2 + kstep; const char* b3 = b2 + kstep;
      PG8_LDB(B0, 0, 0); PG8_SCHED; PG8_LDA(At, 0, 0); PG8_STAGE(PG8_SA(1, 1), a1 + hstepA, voffA);
      PG8_WAIT_L(8); PG8_BAR; PG8_WAIT_L(0); PG8_MMA(0, 0, At, B0); PG8_BAR; PG8_SCHED;
      PG8_LDB(B1, 0, 1); PG8_STAGE(PG8_SB(0, 0), b2, voffB);
      PG8_BAR; PG8_WAIT_L(0); PG8_MMA(0, 1, At, B1); PG8_BAR;
      PG8_LDA(At, 0, 1); PG8_STAGE(PG8_SA(0, 0), a2, voffA);
      PG8_BAR; PG8_WAIT_L(0); PG8_MMA(1, 0, At, B0); PG8_BAR; PG8_SCHED;
      PG8_STAGE(PG8_SB(0, 1), b2 + hstepB, voffB);
      PG8_WAIT_V(6); PG8_BAR; PG8_MMA(1, 1, At, B1); PG8_BAR;
      PG8_LDB(B0, 1, 0); PG8_SCHED; PG8_LDA(At, 1, 0); PG8_STAGE(PG8_SA(0, 1), a2 + hstepA, voffA);
      PG8_WAIT_L(8); PG8_BAR; PG8_WAIT_L(0); PG8_MMA(0, 0, At, B0); PG8_BAR; PG8_SCHED;
      PG8_LDB(B1, 1, 1); PG8_STAGE(PG8_SB(1, 0), b3, voffB);
      PG8_BAR; PG8_WAIT_L(0); PG8_MMA(0, 1, At, B1); PG8_BAR;
      PG8_LDA(At, 1, 1); PG8_STAGE(PG8_SA(1, 0), a3, voffA);
      PG8_BAR; PG8_WAIT_L(0); PG8_MMA(1, 0, At, B0); PG8_BAR; PG8_SCHED;
      PG8_STAGE(PG8_SB(1, 1), b3 + hstepB, voffB);
      PG8_WAIT_V(6); PG8_BAR; PG8_MMA(1, 1, At, B1); PG8_BAR;
    }
    E(acc, cur, wr, wc, fr, fq);
    if (!has_next) break;
#pragma unroll
    for (int a = 0; a < 2; ++a)
#pragma unroll
      for (int b = 0; b < 2; ++b)
#pragma unroll
        for (int m = 0; m < 4; ++m)
#pragma unroll
          for (int n = 0; n < 2; ++n) acc[a][b][m][n] = (f32x4){0.f, 0.f, 0.f, 0.f};
    cur = nxt; cA = nA; cB = nB; ++ui;
  }
  PG8_WAIT_V(0);
  if (wr == 0) PG8_BAR;
  PG8_BAR;
#undef PG8_SA
#undef PG8_SB
#undef PG8_STAGE
#undef PG8_LDA
#undef PG8_LDB
#undef PG8_MMA
#undef PG8_WAIT_V
#undef PG8_WAIT_L
#undef PG8_BAR
#undef PG8_SCHED
}
}
using pg8::Unit;
typedef f32x4 AccT[2][2][4][2];

DI u32x4 pack8(const f32x4& a, const f32x4& b) { u32x4 w; w.x = pk2(a[0], a[1]); w.y = pk2(a[2], a[3]); w.z = pk2(b[0], b[1]); w.w = pk2(b[2], b[3]); return w; }

struct EpiL0Main {
  static constexpr bool PERM = true;
  u16 *Q, *K, *P, *G; const float* rope; unsigned* kpart;
  DI void operator()(const AccT& acc, const Unit& u, int wr, int wc, int fr, int fq) const {
    const int pn = u.pn, row0 = u.pm * 256 + wr * 64 + fr;
    if (pn < 8) {
      const bool isq = pn < 4;
      const float sc = isq ? 0.125f * 1.4426950408889634f : 1.f;
      const int half = wc & 1, hi = fq >> 1, jj0 = 8 * (fq & 1), px = ((fq * 16 + fr) ^ 32) * 4;
      float nmax[2] = {0.f, 0.f};
#pragma unroll
      for (int ai = 0; ai < 2; ++ai)
#pragma unroll
        for (int m = 0; m < 4; ++m) {
          const int row = row0 + ai * 128 + m * 16, t = row & 2047, b = row >> 11;
          const int pos = half ? (t & 63) : (t >> 6);
          const f32x4 c0 = *(const f32x4*)(rope + pos * 16 + jj0), c1 = *(const f32x4*)(rope + pos * 16 + jj0 + 4);
          const f32x4 s0 = *(const f32x4*)(rope + 1024 + pos * 16 + jj0), s1 = *(const f32x4*)(rope + 1024 + pos * 16 + jj0 + 4);
#pragma unroll
          for (int bj = 0; bj < 2; ++bj) {
            f32x4 v0 = acc[ai][bj][m][0], v1 = acc[ai][bj][m][1], p0, p1;
#pragma unroll
            for (int e = 0; e < 4; ++e) { p0[e] = bperm(px, v0[e]); p1[e] = bperm(px, v1[e]); }
            f32x4 o0, o1;
            if (hi) { o0 = v0 * c0 + p0 * s0; o1 = v1 * c1 + p1 * s1; } else { o0 = v0 * c0 - p0 * s0; o1 = v1 * c1 - p1 * s1; }
            o0 *= sc; o1 *= sc;
            nmax[bj] = fmaxf(nmax[bj], (o0[0] * o0[0] + o0[1] * o0[1]) + (o0[2] * o0[2] + o0[3] * o0[3]) + (o1[0] * o1[0] + o1[1] * o1[1]) + (o1[2] * o1[2] + o1[3] * o1[3]));
            const int col = (pn & 3) * 256 + bj * 128 + wc * 32 + 8 * fq, sh = col >> 6, d = col & 63;
            u16* dst = isq ? Q + ((size_t)(b * 16 + sh) * SEQ + t) * 64 + d : K + ((size_t)(b * 16 + sh) * KALL + CTXL + t) * 64 + d;
            *(u32x4*)dst = pack8(o0, o1);
          }
        }
      if (!isq) {
        const int b = (u.pm * 256) >> 11;
#pragma unroll
        for (int bj = 0; bj < 2; ++bj) { const int sh = ((pn & 3) * 256 + bj * 128 + wc * 32) >> 6;
          atomicMax(kpart + (b * 16 + sh) * 8 + (wc & 1) * 4 + fq, __float_as_uint(nmax[bj] * 1.02f)); }
      }
    } else if (pn < 12) {
#pragma unroll
      for (int ai = 0; ai < 2; ++ai)
#pragma unroll
        for (int m = 0; m < 4; ++m) {
          const int row = row0 + ai * 128 + m * 16;
#pragma unroll
          for (int bj = 0; bj < 2; ++bj) {
            const int col = (pn - 8) * 256 + bj * 128 + wc * 32 + 8 * fq;
            *(u32x4*)(P + (size_t)row * 1024 + col) = pack8(acc[ai][bj][m][0], acc[ai][bj][m][1]);
          }
        }
    } else {
#pragma unroll
      for (int ai = 0; ai < 2; ++ai)
#pragma unroll
        for (int m = 0; m < 4; ++m) {
          const int row = row0 + ai * 128 + m * 16;
#pragma unroll
          for (int bj = 0; bj < 2; ++bj) {
            const int col = (pn - 12) * 256 + bj * 128 + wc * 32 + 8 * fq;
            f32x4 v0 = acc[ai][bj][m][0], v1 = acc[ai][bj][m][1];
#pragma unroll
            for (int e = 0; e < 4; ++e) { v0[e] = silu_f(v0[e]); v1[e] = silu_f(v1[e]); }
            *(u32x4*)(G + (size_t)row * 2048 + col) = pack8(v0, v1);
          }
        }
    }
  }
};
struct EpiVt {
  static constexpr bool PERM = true;
  u16* Vt; int shift, toff;
  DI void operator()(const AccT& acc, const Unit& u, int wr, int wc, int fr, int fq) const {
    const int f0 = u.pm * 256 + wr * 64 + fr;
#pragma unroll
    for (int ai = 0; ai < 2; ++ai)
#pragma unroll
      for (int m = 0; m < 4; ++m) {
        const int f = f0 + ai * 128 + m * 16;
#pragma unroll
        for (int bj = 0; bj < 2; ++bj) {
          const int tok = u.pn * 256 + bj * 128 + wc * 32 + 8 * fq, b = tok >> shift, t = tok & ((1 << shift) - 1);
          u16* dst = Vt + ((size_t)(b * 8 + (f >> 7)) * 128 + (f & 127)) * KALL + toff + (t & ~15) + 4 * ((t >> 3) & 1);
          const f32x4 a0 = acc[ai][bj][m][0], a1 = acc[ai][bj][m][1];
          u32x2 w0, w1; w0.x = pk2(a0[0], a0[1]); w0.y = pk2(a0[2], a0[3]); w1.x = pk2(a1[0], a1[1]); w1.y = pk2(a1[2], a1[3]);
          *(u32x2*)dst = w0; *(u32x2*)(dst + 8) = w1;
        }
      }
  }
};
struct EpiCtxK {
  static constexpr bool PERM = true;
  u16* K; unsigned* kpart;
  DI void operator()(const AccT& acc, const Unit& u, int wr, int wc, int fr, int fq) const {
    const int row0 = u.pm * 256 + wr * 64 + fr;
    float nmax[2] = {0.f, 0.f};
#pragma unroll
    for (int ai = 0; ai < 2; ++ai)
#pragma unroll
      for (int m = 0; m < 4; ++m) {
        const int row = row0 + ai * 128 + m * 16, b = row >> 8, t = row & 255;
#pragma unroll
        for (int bj = 0; bj < 2; ++bj) {
          const int col = u.pn * 256 + bj * 128 + wc * 32 + 8 * fq, sh = col >> 6, d = col & 63;
          const f32x4 o0 = acc[ai][bj][m][0], o1 = acc[ai][bj][m][1];
          nmax[bj] = fmaxf(nmax[bj], (o0[0] * o0[0] + o0[1] * o0[1]) + (o0[2] * o0[2] + o0[3] * o0[3]) + (o1[0] * o1[0] + o1[1] * o1[1]) + (o1[2] * o1[2] + o1[3] * o1[3]));
          *(u32x4*)(K + ((size_t)(b * 16 + sh) * KALL + t) * 64 + d) = pack8(o0, o1);
        }
      }
    const int b = u.pm;
#pragma unroll
    for (int bj = 0; bj < 2; ++bj) { const int sh = (u.pn * 256 + bj * 128 + wc * 32) >> 6;
      atomicMax(kpart + (b * 16 + sh) * 8 + (wc & 1) * 4 + fq, __float_as_uint(nmax[bj] * 1.02f)); }
  }
};
struct EpiPool {
  static constexpr bool PERM = true;
  u16* G; const float* pscale; int grp;
  DI void operator()(const AccT& acc, const Unit& u, int wr, int wc, int fr, int fq) const {
    const int row0 = u.pm * 256 + wr * 64 + fr;
#pragma unroll
    for (int bj = 0; bj < 2; ++bj) {
      const int col = grp * 256 + bj * 128 + wc * 32 + 8 * fq;
      const f32x4 ps0 = *(const f32x4*)(pscale + col), ps1 = *(const f32x4*)(pscale + col + 4);
#pragma unroll
      for (int ai = 0; ai < 2; ++ai)
#pragma unroll
        for (int m = 0; m < 4; ++m) {
          const int row = row0 + ai * 128 + m * 16;
          u16* p = G + (size_t)row * 2048 + 1024 + col;
          const u32x4 gv = *(const u32x4*)p;
          f32x4 g0 = {bflo(gv.x), bfhi(gv.x), bflo(gv.y), bfhi(gv.y)}, g1 = {bflo(gv.z), bfhi(gv.z), bflo(gv.w), bfhi(gv.w)};
          *(u32x4*)p = pack8(acc[ai][bj][m][0] * ps0 * g0, acc[ai][bj][m][1] * ps1 * g1);
        }
    }
  }
};
struct EpiResid {
  static constexpr bool PERM = false;
  const float* src; float* dst; const float* gate;
  DI void operator()(const AccT& acc, const Unit& u, int wr, int wc, int fr, int fq) const {
    const int row0 = u.pm * 256 + wr * 64 + fr, col0 = u.pn * 256 + wc * 32 + 4 * fq, b = (u.pm * 256) >> 11;
#pragma unroll
    for (int bj = 0; bj < 2; ++bj)
#pragma unroll
      for (int n = 0; n < 2; ++n) {
        const int col = col0 + bj * 128 + n * 16;
        const f32x4 gt = *(const f32x4*)(gate + b * 1024 + col);
#pragma unroll
        for (int ai = 0; ai < 2; ++ai)
#pragma unroll
          for (int m = 0; m < 4; ++m) {
            const size_t o = (size_t)(row0 + ai * 128 + m * 16) * 1024 + col;
            *(f32x4*)(dst + o) = *(const f32x4*)(src + o) + gt * acc[ai][bj][m][n];
          }
      }
  }
};
struct EpiPlain {
  static constexpr bool PERM = true;
  u16* O; int ldc;
  DI void operator()(const AccT& acc, const Unit& u, int wr, int wc, int fr, int fq) const {
    const int row0 = u.pm * 256 + wr * 64 + fr, col0 = u.pn * 256 + wc * 32 + 8 * fq;
#pragma unroll
    for (int ai = 0; ai < 2; ++ai)
#pragma unroll
      for (int m = 0; m < 4; ++m)
#pragma unroll
        for (int bj = 0; bj < 2; ++bj)
          *(u32x4*)(O + (size_t)(row0 + ai * 128 + m * 16) * ldc + col0 + bj * 128) = pack8(acc[ai][bj][m][0], acc[ai][bj][m][1]);
  }
};

template <class Epi>
DI void run_gemm(int wv, LAS unsigned char* lds, const u16* A, int lda, const u16* Bt, int ldb, int M, int N, int K, int coff, const Epi& E) {
  asm volatile("" : "+s"(K));
  pg8::Gemm g; g.A = A; g.Bt = Bt; g.M = M; g.N = N; g.K = K; g.lda = lda; g.ldb = ldb;
  pg8::StaticOrder S; S.init(M, N, (int)gridDim.x, (int)((blockIdx.x + coff) % gridDim.x));
  pg8::gemm_phase<Epi>(lds, g, S, E, wv);
  __syncthreads();
}

DI void tr_item(const float* W, int K, int N, u16* WT, int k0, int n0, int drow0, LAS float* scr, int lane) {
#pragma unroll
  for (int i = 0; i < 32; ++i) { const int kk = 2 * i + (lane >> 5); scr[kk * 33 + (lane & 31)] = W[(size_t)(k0 + kk) * N + n0 + (lane & 31)]; }
  __builtin_amdgcn_wave_barrier();
  const int c = lane & 7;
#pragma unroll
  for (int j = 0; j < 4; ++j) { const int n = (lane >> 3) + 8 * j; const LAS float* s = scr + (8 * c) * 33 + n;
    u32x4 o; o.x = pk2(s[0 * 33], s[1 * 33]); o.y = pk2(s[2 * 33], s[3 * 33]); o.z = pk2(s[4 * 33], s[5 * 33]); o.w = pk2(s[6 * 33], s[7 * 33]);
    *(u32x4*)(WT + (size_t)(drow0 + n) * K + k0 + 8 * c) = o; }
  __builtin_amdgcn_wave_barrier();
}

DI void phase0(const Params& p, LAS unsigned char* lds, int wv) {
  const int lane = lane_id(), wave = wv, tid = wv * 64 + lane, bid = blockIdx.x, G = gridDim.x;
  unsigned char* ws = p.ws;
  {
    LAS float* sc = (LAS float*)lds;
    for (int item = bid; item < 96; item += G) {
      const int l = item / 48, r2 = item % 48, ks = r2 / 6, cb = r2 % 6;
      __syncthreads();
      for (int i = tid; i < 17 * 128; i += 512) { const int rr = i >> 7, k = ks * 128 + (i & 127); const float cv = rr < 16 ? p.in[I_C][rr * 1024 + k] : p.in[I_CCTX][k]; sc[i] = silu_f(cv); }
      __syncthreads();
      const int j = cb * 512 + tid;
      float a[17];
#pragma unroll
      for (int rr = 0; rr < 17; ++rr) a[rr] = 0.f;
      const float* W = p.in[I_ADAW] + (size_t)l * 1024 * 3072 + (size_t)(ks * 128) * 3072 + j;
#pragma unroll 16
      for (int kk = 0; kk < 128; ++kk) { const float w = W[(size_t)kk * 3072];
#pragma unroll
        for (int rr = 0; rr < 17; ++rr) a[rr] += sc[rr * 128 + kk] * w; }
      float* o = (float*)(ws + WS_ADAP) + (size_t)((l * 8 + ks) * 17) * 3072 + j;
#pragma unroll
      for (int rr = 0; rr < 17; ++rr) o[(size_t)rr * 3072] = a[rr];
    }
    __syncthreads();
  }
  if (bid == G - 1) {
    float* rope = (float*)(ws + WS_ROPE);
    for (int i = tid; i < 1024; i += 512) { const int pos = i >> 4, jj = i & 15; const float inv = powf(10000.f, -(float)jj / 16.f), ang = (float)pos * inv; rope[i] = cosf(ang); rope[1024 + i] = sinf(ang); }
  }
  {
    LAS float* mw = (LAS float*)(lds + 71680);
    __syncthreads();
#pragma unroll
    for (int q = 0; q < 5; ++q) { const int i = tid + 512 * q; if (i < 2112) mw[i] = p.in[I_FW0][i]; }
#pragma unroll
    for (int q = 0; q < 8; ++q) { const int i = tid + 512 * q; mw[2112 + i] = p.in[I_FW1][i]; mw[6208 + i] = p.in[I_FW2][i]; }
    __syncthreads();
    for (int t = bid * 8 + wave; t < SEQ; t += G * 8) {
      const float tl = (float)t / 2047.f, w = 6.283185307179586f * (float)t / 2048.f;
      float zv = 0.f;
      if (lane == 0) zv = tl;
      else if (lane < 33) { const int i = (lane - 1) & 15; const float band = 1e-4f + (float)i * ((15.f - 1e-4f) / 15.f); zv = lane < 17 ? cosf(band * w) : -sinf(band * w); }
      float a = 0.f;
#pragma unroll
      for (int i = 0; i < 33; ++i) a += __uint_as_float(__builtin_amdgcn_readlane(__float_as_uint(zv), i)) * mw[i * 64 + lane];
      float h = sinf(p.in[I_FF0][lane] * (a + p.in[I_FB0][lane]));
      a = 0.f;
#pragma unroll
      for (int i = 0; i < 64; ++i) a += __uint_as_float(__builtin_amdgcn_readlane(__float_as_uint(h), i)) * mw[2112 + i * 64 + lane];
      h = sinf(p.in[I_FF1][lane] * (a + p.in[I_FB1][lane]));
      a = 0.f;
#pragma unroll
      for (int i = 0; i < 64; ++i) a += __uint_as_float(__builtin_amdgcn_readlane(__float_as_uint(h), i)) * mw[6208 + i * 64 + lane];
      h = sinf(p.in[I_FF2][lane] * (a + p.in[I_FB2][lane]));
      ((float*)(ws + WS_H3))[t * 64 + lane] = h;
    }
  }
  {
    LAS float* scr = (LAS float*)lds + wave * (64 * 33);
    constexpr int I_A = 16 * 192, I_AO = 32 * 32, I_P = 128, I_H = 16 * 256, I_HO = 32 * 32, NIT = I_A + I_AO + I_P + I_H + I_HO;
    for (int it = bid * 8 + wave; it < NIT; it += G * 8) {
      int r = it;
      if (r < I_A) { const int kb = r / 192, nb = r % 192, n0 = nb * 32; const int drow = n0 < 2048 ? n0 : (n0 < 3072 ? n0 + 3072 : n0 - 1024);
        tr_item(p.in[I_AWIN], 1024, 6144, (u16*)(ws + WS_WA), kb * 64, n0, drow, scr, lane); continue; } r -= I_A;
      if (r < I_AO) { const int kb = r / 32, nb = r % 32; tr_item(p.in[I_AWOUT], 2048, 1024, (u16*)(ws + WS_WAO), kb * 64, nb * 32, nb * 32, scr, lane); continue; } r -= I_AO;
      if (r < I_P) { const int g = r / 32, q = r % 32, kb = q / 8, nb = q % 8; tr_item(p.in[I_POOLW] + g * 65536, 256, 256, (u16*)(ws + WS_PW) + g * 65536, kb * 64, nb * 32, nb * 32, scr, lane); continue; } r -= I_P;
      if (r < I_H) { const int kb = r / 256, nb = r % 256, n0 = nb * 32; const int part = n0 >> 11, c = n0 & 2047; const int drow = (c >> 9) * 2048 + part * 512 + (c & 511);
        tr_item(p.in[I_HWIN], 1024, 8192, (u16*)(ws + WS_WH), kb * 64, n0, drow, scr, lane); continue; } r -= I_H;
      { const int kb = r / 32, nb = r % 32; tr_item(p.in[I_HWOUT], 2048, 1024, (u16*)(ws + WS_WHO), kb * 64, nb * 32, nb * 32, scr, lane); }
    }
  }
}

DI void mod_vectors(const Params& p, int wv, int l, int r, LAS float* gs, LAS float* sh, float* gate_out) {
  const float* adaP = (const float*)(p.ws + WS_ADAP);
  for (int j = OTID(wv); j < 1024; j += 512) {
    float s0 = p.in[I_ADAB][l * 3072 + j], s1 = p.in[I_ADAB][l * 3072 + 1024 + j], s2 = p.in[I_ADAB][l * 3072 + 2048 + j];
#pragma unroll
    for (int ks = 0; ks < 8; ++ks) { const float* a = adaP + (size_t)((l * 8 + ks) * 17 + r) * 3072 + j; s0 += a[0]; s1 += a[1024]; s2 += a[2048]; }
    sh[j] = s0; gs[j] = p.in[I_NORMG][l * 1024 + j] * (1.f + s1);
    if (gate_out) gate_out[j] = s2;
  }
}
DI void mod_row(const float* xrow, u16* orow, const LAS float* gs, const LAS float* sh, int lane) {
  f32x4 v[4]; float ss = 0.f;
#pragma unroll
  for (int j = 0; j < 4; ++j) { v[j] = *(const f32x4*)(xrow + 4 * lane + 256 * j); ss += (v[j][0] * v[j][0] + v[j][1] * v[j][1]) + (v[j][2] * v[j][2] + v[j][3] * v[j][3]); }
  const float rstd = rsqrtf(wave_sum(ss) * (1.f / 1024.f) + 1e-6f);
#pragma unroll
  for (int j = 0; j < 4; ++j) {
    const int c = 4 * lane + 256 * j;
    const f32x4 g4 = *(const LAS f32x4*)(gs + c), s4 = *(const LAS f32x4*)(sh + c);
    const f32x4 o = v[j] * rstd * g4 + s4;
    u32x2 w; w.x = pk2(o[0], o[1]); w.y = pk2(o[2], o[3]);
    *(u32x2*)(orow + c) = w;
  }
}

DI void phase1(const Params& p, LAS unsigned char* lds, int wv) {
  const int lane = lane_id(), wave = wv, tid = wv * 64 + lane, bid = blockIdx.x, G = gridDim.x;
  unsigned char* ws = p.ws;
  {
    const float* H3 = (const float*)(ws + WS_H3);
    const float* wout = p.in[I_FWOUT];
    u16* F = (u16*)(ws + WS_F);
    const float mind = -3.0701134573253945f, maxd = -15.350567286626973f;
    LAS float* Hs = (LAS float*)lds;
    LAS float* Wl = (LAS float*)(lds + 16384) + wave * 2048;
    for (int it = bid; it < 1024; it += G) {
      const int tb = it & 31, cs = it >> 5, t = tb * 64 + lane, colb = cs * 256 + wave * 32, dir = (colb >> 11) & 1, o = colb >> 12;
      __syncthreads();
#pragma unroll
      for (int q = 0; q < 2; ++q) { const int idx = tid + 512 * q, tt = idx >> 4, j4 = idx & 15;
        const f32x4 h4 = *(const f32x4*)(H3 + (size_t)(tb * 64 + tt) * 64 + j4 * 4);
        Hs[(4 * j4) * 64 + tt] = h4[0]; Hs[(4 * j4 + 1) * 64 + tt] = h4[1]; Hs[(4 * j4 + 2) * 64 + tt] = h4[2]; Hs[(4 * j4 + 3) * 64 + tt] = h4[3]; }
#pragma unroll
      for (int q = 0; q < 8; ++q) { const int j = q * 8 + (lane >> 3), c4 = lane & 7;
        *(LAS f32x4*)(Wl + j * 32 + c4 * 4) = *(const f32x4*)(wout + (size_t)j * 8192 + colb + c4 * 4); }
      __syncthreads();
      f32x4 acc[8];
#pragma unroll
      for (int c = 0; c < 8; ++c) acc[c] = (f32x4){0.f, 0.f, 0.f, 0.f};
#pragma unroll 4
      for (int j = 0; j < 64; ++j) {
        const float h = Hs[j * 64 + lane];
#pragma unroll
        for (int c = 0; c < 8; ++c) acc[c] += h * *(const LAS f32x4*)(Wl + j * 32 + c * 4);
      }
      const float tl = (float)t / 2047.f;
#pragma unroll
      for (int c = 0; c < 8; ++c)
#pragma unroll
        for (int e = 0; e < 4; ++e) {
          const int cch = (colb + c * 4 + e) & 2047;
          const float delta = fabsf(mind + (float)cch * ((maxd - mind) / 2047.f));
          const float val = acc[c][e] * expf(-tl * delta);
          u16* Fr = F + (size_t)(cch * 2 + o) * 4096;
          const int idx = dir == 0 ? 2047 - t : (t > 0 ? 2047 + t : 4095);
          Fr[idx] = (dir == 1 && t == 0) ? (u16)0 : (u16)(pk2(val, 0.f) & 0xffffu);
        }
    }
  }
  {
    LAS float* gs = (LAS float*)lds; LAS float* sh = gs + 1024; LAS float* gsc = sh + 1024; LAS float* shc = gsc + 1024;
    const int b = bid >> 4;
    float* gate = (float*)(ws + WS_GATE);
    __syncthreads();
    mod_vectors(p, wv, 0, b, gs, sh, (bid & 15) == 0 ? gate + b * 1024 : nullptr);
    mod_vectors(p, wv, 0, 16, gsc, shc, nullptr);
    __syncthreads();
    for (int i = 0; i < 16; ++i) { const int row = bid * 128 + wave * 16 + i; mod_row(p.in[I_X] + (size_t)row * 1024, (u16*)(ws + WS_H) + (size_t)row * 1024, gs, sh, lane); }
    for (int i = 0; i < 2; ++i) { const int row = bid * 16 + wave * 2 + i; mod_row(p.in[I_CTX] + (size_t)row * 1024, (u16*)(ws + WS_HC) + (size_t)row * 1024, gsc, shc, lane); }
    __syncthreads();
  }
}

DI void pool_means(const Params& p, int wv) {
  const u16* P = (const u16*)((unsigned char*)p.out + 64 * MB);
  u16* M4 = (u16*)(p.ws + WS_H);
  for (int gid = blockIdx.x * 512 + OTID(wv); gid < NB * 64 * 128; gid += gridDim.x * 512) {
    const int ch = gid & 127, r = (gid >> 7) & 63, b = gid >> 13, gi = ch >> 5, hw = 1 << gi;
    const u16* base = P + (size_t)b * SEQ * 1024 + ch * 8;
    const int t0 = r * 32;
    float s[8];
#pragma unroll
    for (int e = 0; e < 8; ++e) s[e] = 0.f;
    for (int q = t0 - hw; q < t0 + hw; ++q) if (q >= 0 && q < SEQ) { const u32x4 v = *(const u32x4*)(base + (size_t)q * 1024);
      s[0] += bflo(v.x); s[1] += bfhi(v.x); s[2] += bflo(v.y); s[3] += bfhi(v.y); s[4] += bflo(v.z); s[5] += bfhi(v.z); s[6] += bflo(v.w); s[7] += bfhi(v.w); }
#pragma unroll 4
    for (int t = t0; t < t0 + 32; ++t) {
      const int lo = max(t - hw, 0), hi = min(t + hw, SEQ);
      const float inv = 1.f / (float)(hi - lo);
      const u32x4 c = *(const u32x4*)(base + (size_t)t * 1024);
      u32x4 o;
      o.x = pk2(s[0] * inv - bflo(c.x), s[1] * inv - bfhi(c.x)); o.y = pk2(s[2] * inv - bflo(c.y), s[3] * inv - bfhi(c.y));
      o.z = pk2(s[4] * inv - bflo(c.z), s[5] * inv - bfhi(c.z)); o.w = pk2(s[6] * inv - bflo(c.w), s[7] * inv - bfhi(c.w));
      *(u32x4*)(M4 + ((size_t)b * SEQ + t) * 1024 + ch * 8) = o;
      if (t + hw < SEQ) { const u32x4 v = *(const u32x4*)(base + (size_t)(t + hw) * 1024);
        s[0] += bflo(v.x); s[1] += bfhi(v.x); s[2] += bflo(v.y); s[3] += bfhi(v.y); s[4] += bflo(v.z); s[5] += bfhi(v.z); s[6] += bflo(v.w); s[7] += bfhi(v.w); }
      if (t - hw >= 0) { const u32x4 v = *(const u32x4*)(base + (size_t)(t - hw) * 1024);
        s[0] -= bflo(v.x); s[1] -= bfhi(v.x); s[2] -= bflo(v.y); s[3] -= bfhi(v.y); s[4] -= bflo(v.z); s[5] -= bfhi(v.z); s[6] -= bflo(v.w); s[7] -= bfhi(v.w); }
    }
  }
}

constexpr int AT_KSTR = 144, AT_VSTR = 144, AT_K1 = 9216, AT_V = 18432, AT_STAGE = 36864;
#define MFMA32(a, b, c) __builtin_amdgcn_mfma_f32_32x32x16_bf16((a), (b), (c), 0, 0, 0)
template <bool ZS> DI void att_tile(const LAS unsigned char* st, int sub, int ql, int hh, const bf16x8 (&qf)[4], float nshift, f32x16 (&O)[4], float& l) {
  const LAS unsigned char* kb_ = st + sub * AT_K1 + ql * AT_KSTR + 16 * hh;
  const LAS unsigned char* vb_ = st + AT_V + ql * AT_VSTR + 16 * hh;
  f32x16 S[2];
#pragma unroll
  for (int kb = 0; kb < 2; ++kb) {
#pragma unroll
    for (int r = 0; r < 16; ++r) S[kb][r] = ZS ? 0.f : nshift;
#pragma unroll
    for (int ks = 0; ks < 4; ++ks) { const bf16x8 kf = *(const LAS bf16x8*)(kb_ + kb * (32 * AT_KSTR) + ks * 32); S[kb] = MFMA32(kf, qf[ks], S[kb]); }
  }
  float ps = 0.f;
#pragma unroll
  for (int kb = 0; kb < 2; ++kb)
#pragma unroll
    for (int r = 0; r < 16; ++r) { const float e = __builtin_amdgcn_exp2f(S[kb][r]); S[kb][r] = e; ps += e; }
  l += ps;
#pragma unroll
  for (int kb = 0; kb < 2; ++kb)
#pragma unroll
    for (int s2 = 0; s2 < 2; ++s2) {
      u32x4 pw; pw.x = pk2(S[kb][8 * s2], S[kb][8 * s2 + 1]); pw.y = pk2(S[kb][8 * s2 + 2], S[kb][8 * s2 + 3]); pw.z = pk2(S[kb][8 * s2 + 4], S[kb][8 * s2 + 5]); pw.w = pk2(S[kb][8 * s2 + 6], S[kb][8 * s2 + 7]);
      const bf16x8 pf = __builtin_bit_cast(bf16x8, pw);
#pragma unroll
      for (int blk = 0; blk < 4; ++blk) {
        const LAS unsigned char* va = vb_ + blk * (32 * AT_VSTR) + (32 * kb + 16 * s2) * 2;
        O[blk] = MFMA32(*(const LAS bf16x8*)va, pf, O[blk]);
      }
    }
}
DI void attention_phase(const Params& p, LAS unsigned char* lds, int wv, bool dry = false) {
  const int lane = lane_id(), tid = wv * 64 + lane;
  const int sub = wv >> 2, qg = wv & 3, ql = lane & 31, hh = lane >> 5, px = (lane ^ 32) * 4;
  const u16* Qb = (const u16*)p.out; const u16* Kb = (const u16*)(p.ws + WS_K); const u16* Vtb = (const u16*)(p.ws + WS_VT); u16* G = (u16*)(p.ws + WS_G);
  float lam;
  { const float a = p.in[I_LQ1][lane] * p.in[I_LK1][lane], b2 = p.in[I_LQ2][lane] * p.in[I_LK2][lane]; lam = expf(wave_sum(a)) - expf(wave_sum(b2)) + 0.2f; }
  const int krow = tid >> 3, kc = tid & 7;
  const unsigned koff = (unsigned)(krow * 128 + kc * 16), voff = (unsigned)(krow * (KALL * 2) + kc * 16);
  for (int it = 0; it < 8; ++it) {
    const int xj = blockIdx.x >> 3, bh = it * 16 + (blockIdx.x & 7) * 2 + (xj >> 4), qblk = xj & 15, b = bh >> 3, h = bh & 7;
    const char* kbase = (const char*)(Kb + (size_t)(b * 16 + 2 * h) * KALL * 64);
    const char* vbase = (const char*)(Vtb + (size_t)(b * 8 + h) * 128 * KALL);
    const int qrow = qblk * 128 + qg * 32 + ql;
    const u16* qp = Qb + ((size_t)(b * 16 + 2 * h + sub) * SEQ + qrow) * 64 + 8 * hh;
    bf16x8 qf[4];
#pragma unroll
    for (int ks = 0; ks < 4; ++ks) qf[ks] = *(const bf16x8*)(qp + 16 * ks);
    float nshift;
    { const float* kp = (const float*)(p.ws + WS_KPART) + (b * 16 + 2 * h + sub) * 8;
      float k2 = 0.f;
#pragma unroll
      for (int e = 0; e < 8; ++e) k2 += kp[e];
      float q2 = 0.f;
#pragma unroll
      for (int ks = 0; ks < 4; ++ks)
#pragma unroll
        for (int e = 0; e < 8; ++e) { const float qv = bf1((u16)qf[ks][e]); q2 += qv * qv; }
      q2 += bperm(px, q2);
      nshift = -sqrtf(q2 * k2); }
    const bool zs = __builtin_amdgcn_ballot_w64(nshift < -100.f) == 0ull;
    u32x4 ra[4];
#define AT_LOAD(kt_) do { const char* kb_ = kbase + (size_t)(kt_) * 8192; const char* vb_ = vbase + (size_t)(kt_) * 128; \
      ra[0] = *(const u32x4*)(kb_ + koff); ra[1] = *(const u32x4*)(kb_ + (size_t)KALL * 128 + koff); ra[2] = *(const u32x4*)(vb_ + voff); ra[3] = *(const u32x4*)(vb_ + (size_t)64 * KALL * 2 + voff); } while (0)
#define AT_WRITE(sn_) do { LAS unsigned char* s_ = (sn_); \
      *(LAS u32x4*)(s_ + krow * AT_KSTR + kc * 16) = ra[0]; *(LAS u32x4*)(s_ + AT_K1 + krow * AT_KSTR + kc * 16) = ra[1]; \
      *(LAS u32x4*)(s_ + AT_V + krow * AT_VSTR + kc * 16) = ra[2]; *(LAS u32x4*)(s_ + AT_V + (64 + krow) * AT_VSTR + kc * 16) = ra[3]; } while (0)
    AT_LOAD(0);
    __syncthreads();
    AT_WRITE(lds);
    __syncthreads();
    f32x16 O[4];
#pragma unroll
    for (int blk = 0; blk < 4; ++blk)
#pragma unroll
      for (int r = 0; r < 16; ++r) O[blk][r] = 0.f;
    float l = 0.f;
    if (zs) {
      for (int kt = 0; kt < KALL / 64; ++kt) {
        const bool more = kt + 1 < KALL / 64;
        if (more) AT_LOAD(kt + 1);
        att_tile<true>(lds + (kt & 1) * AT_STAGE, sub, ql, hh, qf, 0.f, O, l);
        if (more) AT_WRITE(lds + ((kt + 1) & 1) * AT_STAGE);
        __syncthreads();
      }
    } else {
      for (int kt = 0; kt < KALL / 64; ++kt) {
        const bool more = kt + 1 < KALL / 64;
        if (more) AT_LOAD(kt + 1);
        att_tile<false>(lds + (kt & 1) * AT_STAGE, sub, ql, hh, qf, nshift, O, l);
        if (more) AT_WRITE(lds + ((kt + 1) & 1) * AT_STAGE);
        __syncthreads();
      }
    }
#undef AT_LOAD
#undef AT_WRITE
    l += bperm(px, l);
    const float invl = 1.f / l;
    LAS float* X = (LAS float*)lds + qg * 4096;
    if (sub == 1) {
#pragma unroll
      for (int blk = 0; blk < 4; ++blk)
#pragma unroll
        for (int r = 0; r < 16; ++r) { const int dv = 32 * blk + (r & 3) + 8 * (r >> 2) + 4 * hh; X[dv * 32 + ql] = O[blk][r] * invl; }
    }
    __syncthreads();
    if (sub == 0) {
      float ss = 0.f;
#pragma unroll
      for (int blk = 0; blk < 4; ++blk)
#pragma unroll
        for (int r = 0; r < 16; ++r) { const int dv = 32 * blk + (r & 3) + 8 * (r >> 2) + 4 * hh; const float o = O[blk][r] * invl - lam * X[dv * 32 + ql]; O[blk][r] = o; ss += o * o; }
      ss += bperm(px, ss);
      const float rinv = rsqrtf(ss * (1.f / 128.f) + 1e-5f) * 0.8f;
      u16* grow = G + (size_t)(b * SEQ + qrow) * 2048 + h * 128;
#pragma unroll
      for (int blk = 0; blk < 4; ++blk)
#pragma unroll
        for (int g4 = 0; g4 < 4; ++g4) {
          const int dv = 32 * blk + 8 * g4 + 4 * hh;
          const f32x4 sg = *(const f32x4*)(p.in[I_SUBLN] + dv);
          const u32x2 gg = *(const u32x2*)(grow + dv);
          u32x2 o;
          o.x = pk2(O[blk][4 * g4] * rinv * sg[0] * bflo(gg.x), O[blk][4 * g4 + 1] * rinv * sg[1] * bfhi(gg.x));
          o.y = pk2(O[blk][4 * g4 + 2] * rinv * sg[2] * bflo(gg.y), O[blk][4 * g4 + 3] * rinv * sg[3] * bfhi(gg.y));
          if (dry) *(u32x2*)((u16*)(p.ws + WS_HC) + (size_t)(b * SEQ + qrow) * 128 + dv) = o; else *(u32x2*)(grow + dv) = o;
        }
    }
  }
  __syncthreads();
}

constexpr int CV_USTR = 4112;
constexpr int CV_FL = 66048;
constexpr int CV_FW = 2064;
DI void toeplitz_mma(f32x4 (&acc)[16], const LAS unsigned* FLo, const LAS unsigned char* U, int wv, int lane) {
  const int i = lane & 15, kq = lane >> 4;
  const int base = 2047 - 256 * wv - i + 8 * kq;
  const LAS unsigned* fl = FLo + (base & 1) * CV_FW + (base >> 1);
  const LAS unsigned char* ub = U + i * CV_USTR + kq * 16;
  bf16x8 win[16];
#pragma unroll
  for (int a = 0; a < 16; ++a) { const LAS unsigned* q = fl - 8 * a; u32x4 w = {q[0], q[1], q[2], q[3]}; win[a] = __builtin_bit_cast(bf16x8, w); }
  for (int so = 0; so < 8; ++so) {
#pragma unroll
    for (int si = 0; si < 8; ++si) {
      const int sg = so * 8 + si;
      const bf16x8 bfr = *(const LAS bf16x8*)(ub + 64 * sg);
      const LAS unsigned* q0 = fl + 16 * sg + 16; const LAS unsigned* q1 = fl + 16 * sg + 8;
      const u32x4 w0 = {q0[0], q0[1], q0[2], q0[3]}, w1 = {q1[0], q1[1], q1[2], q1[3]};
#pragma unroll
      for (int a = 0; a < 16; ++a) acc[a] = __builtin_amdgcn_mfma_f32_16x16x32_bf16(win[(a - 2 * si + 16) & 15], bfr, acc[a], 0, 0, 0);
      win[(-2 * si - 2 + 32) & 15] = __builtin_bit_cast(bf16x8, w0);
      win[(-2 * si - 1 + 32) & 15] = __builtin_bit_cast(bf16x8, w1);
    }
  }
}
DI f32x4 sconv4(const u16* row, int t, float w0, float w1, float w2, float cb) {
  const u32x2 c = *(const u32x2*)(row + t);
  const float xm = t > 0 ? bf1(row[t - 1]) : 0.f, xp = t + 4 < SEQ ? bf1(row[t + 4]) : 0.f;
  const float x0 = bflo(c.x), x1 = bfhi(c.x), x2 = bflo(c.y), x3 = bfhi(c.y);
  f32x4 r; r[0] = cb + w0 * xm + w1 * x0 + w2 * x1; r[1] = cb + w0 * x0 + w1 * x1 + w2 * x2; r[2] = cb + w0 * x1 + w1 * x2 + w2 * x3; r[3] = cb + w0 * x2 + w1 * x3 + w2 * xp;
  return r;
}
constexpr int CV_X = 65792;
constexpr int CV_FL1 = 131584;
DI void conv_load_row(const u16* row, const u16* grow, LAS unsigned char* dst, float w0, float w1, float w2, float cb, int tid) {
  u32x4 cur[8], gt[8]; unsigned hm[8], hp[8];
  const bool first = (tid & 255) == 0, last = (tid & 255) == 255;
  const u16* r = row + (size_t)tid * 8;
#pragma unroll
  for (int kj = 0; kj < 8; ++kj) {
    const u16* rk = r + (size_t)kj * 4096;
    cur[kj] = *(const u32x4*)rk;
    hm[kj] = first ? 0u : (unsigned)rk[-1];
    hp[kj] = last ? 0u : (unsigned)rk[8];
  }
  if (grow) {
    const u16* g = grow + (size_t)tid * 8;
#pragma unroll
    for (int kj = 0; kj < 8; ++kj) gt[kj] = *(const u32x4*)(g + (size_t)kj * 4096);
  }
#pragma unroll
  for (int kj = 0; kj < 8; ++kj) {
    const int k = tid + 512 * kj, b = k >> 8, t0 = (k & 255) * 8;
    const u32x4 c4 = cur[kj];
    float x[10]; x[0] = __uint_as_float(hm[kj] << 16); x[1] = bflo(c4.x); x[2] = bfhi(c4.x); x[3] = bflo(c4.y); x[4] = bfhi(c4.y); x[5] = bflo(c4.z); x[6] = bfhi(c4.z); x[7] = bflo(c4.w); x[8] = bfhi(c4.w); x[9] = __uint_as_float(hp[kj] << 16);
    float y[8];
#pragma unroll
    for (int e = 0; e < 8; ++e) y[e] = cb + w0 * x[e] + w1 * x[e + 1] + w2 * x[e + 2];
    if (grow) { const u32x4 g = gt[kj];
      y[0] *= silu_f(bflo(g.x)); y[1] *= silu_f(bfhi(g.x)); y[2] *= silu_f(bflo(g.y)); y[3] *= silu_f(bfhi(g.y)); y[4] *= silu_f(bflo(g.z)); y[5] *= silu_f(bfhi(g.z)); y[6] *= silu_f(bflo(g.w)); y[7] *= silu_f(bfhi(g.w)); }
    u32x4 o; o.x = pk2(y[0], y[1]); o.y = pk2(y[2], y[3]); o.z = pk2(y[4], y[5]); o.w = pk2(y[6], y[7]);
    *(LAS u32x4*)(dst + b * CV_USTR + t0 * 2) = o;
  }
}
DI void conv_load_filter(const u16* Fco, LAS unsigned* FLw, int tid) {
  const unsigned* Fg = (const unsigned*)Fco;
#pragma unroll
  for (int kj = 0; kj < 4; ++kj) { const int k = tid + 512 * kj; const unsigned w0 = Fg[k], w1 = (k + 1 < 2048) ? Fg[k + 1] : 0u;
    FLw[k] = w0; FLw[CV_FW + k] = (w0 >> 16) | (w1 << 16); }
  if (tid < 16) { FLw[2048 + tid] = 0u; FLw[CV_FW + 2048 + tid] = 0u; }
}
DI void conv_phase(const Params& p, LAS unsigned char* lds, int grp, int wv) {
  const int lane = lane_id(), tid = wv * 64 + lane;
  const u16* Ut = (const u16*)(p.ws + WS_UT);
  const u16* F = (const u16*)(p.ws + WS_F);
  u16* Zt = (u16*)(p.ws + WS_ZT);
  LAS unsigned* FLw = (LAS unsigned*)(lds + CV_FL1);
  const float* cw = p.in[I_CONVW]; const float* cbp = p.in[I_CONVB]; const float* fb = p.in[I_FBIAS];
  for (int ci = 0; ci < 2; ++ci) {
    const int cc = blockIdx.x * 2 + ci, c = grp * 512 + cc;
    __syncthreads();
    conv_load_filter(F + (size_t)(c * 2) * 4096, FLw, tid);
    conv_load_row(Ut + (size_t)cc * NTOK, nullptr, lds, cw[c], cw[6144 + c], cw[2 * 6144 + c], cbp[c], tid);
    conv_load_row(Ut + (size_t)(512 + cc) * NTOK, nullptr, lds + CV_X, cw[2048 + c], cw[6144 + 2048 + c], cw[2 * 6144 + 2048 + c], cbp[2048 + c], tid);
    __syncthreads();
    f32x4 acc[16];
#pragma unroll
    for (int a = 0; a < 16; ++a) acc[a] = (f32x4){0.f, 0.f, 0.f, 0.f};
    toeplitz_mma(acc, FLw, lds, wv, lane);
    {
      const int l2 = lane_id(), b = l2 & 15, kq = l2 >> 4;
      const float bias = fb[c];
#pragma unroll
      for (int a = 0; a < 16; ++a) {
        const int t = 256 * wv + 16 * a + 4 * kq;
        const u32x2 uu = *(const LAS u32x2*)(lds + b * CV_USTR + t * 2), xx = *(const LAS u32x2*)(lds + CV_X + b * CV_USTR + t * 2);
        const f32x4 u4 = {bflo(uu.x), bfhi(uu.x), bflo(uu.y), bfhi(uu.y)}, x4 = {bflo(xx.x), bfhi(xx.x), bflo(xx.y), bfhi(xx.y)};
        acc[a] = x4 * (acc[a] + bias * u4);
      }
    }
    __syncthreads();
    { const int l2 = lane_id(), b = l2 & 15, kq = l2 >> 4;
#pragma unroll
      for (int a = 0; a < 16; ++a) {
        const int t = 256 * wv + 16 * a + 4 * kq;
        u32x2 o; o.x = pk2(acc[a][0], acc[a][1]); o.y = pk2(acc[a][2], acc[a][3]);
        *(LAS u32x2*)(lds + b * CV_USTR + t * 2) = o;
        acc[a] = (f32x4){0.f, 0.f, 0.f, 0.f};
      } }
    { const int t2 = wv * 64 + lane_id();
      conv_load_filter(F + (size_t)(c * 2 + 1) * 4096, FLw, t2);
      conv_load_row(Ut + (size_t)(1024 + cc) * NTOK, Ut + (size_t)(1536 + cc) * NTOK, lds + CV_X, cw[4096 + c], cw[6144 + 4096 + c], cw[2 * 6144 + 4096 + c], cbp[4096 + c], t2); }
    __syncthreads();
    toeplitz_mma(acc, FLw, lds, wv, lane);
    {
      const int l2 = lane_id(), b = l2 & 15, kq = l2 >> 4;
      const float bias = fb[2048 + c];
#pragma unroll
      for (int a = 0; a < 16; ++a) {
        const int t = 256 * wv + 16 * a + 4 * kq;
        const u32x2 uu = *(const LAS u32x2*)(lds + b * CV_USTR + t * 2), xx = *(const LAS u32x2*)(lds + CV_X + b * CV_USTR + t * 2);
        const f32x4 z4 = {bflo(uu.x), bfhi(uu.x), bflo(uu.y), bfhi(uu.y)}, x4 = {bflo(xx.x), bfhi(xx.x), bflo(xx.y), bfhi(xx.y)};
        const f32x4 r = x4 * (acc[a] + bias * z4);
        u32x2 o; o.x = pk2(r[0], r[1]); o.y = pk2(r[2], r[3]);
        *(LAS u32x2*)(lds + CV_X + b * CV_USTR + t * 2) = o;
      }
    }
    __syncthreads();
    { const int t2 = wv * 64 + lane_id();
      u16* zrow = Zt + (size_t)c * NTOK;
#pragma unroll
      for (int kj = 0; kj < 8; ++kj) { const int k = t2 + 512 * kj, b = k >> 8, t0 = (k & 255) * 8;
        *(u32x4*)(zrow + (size_t)k * 8) = *(const LAS u32x4*)(lds + CV_X + b * CV_USTR + t0 * 2); } }
  }
  __syncthreads();
}

DI void transpose_phase(const Params& p, LAS unsigned char* lds, int wv) {
  const int lane = lane_id(), wave = wv;
  const u16* Zt = (const u16*)(p.ws + WS_ZT); u16* Z = (u16*)(p.ws + WS_Z);
  LAS unsigned char* scr = lds + wave * 9344;
  for (int it = blockIdx.x * 8 + wave; it < 32 * 512; it += gridDim.x * 8) {
    const int cb = it & 31, tb = it >> 5, c0 = cb * 64, tok0 = tb * 64;
#pragma unroll
    for (int i = 0; i < 8; ++i) { const int cr = (lane >> 3) + 8 * i, tc = lane & 7;
      *(LAS u32x4*)(scr + cr * 144 + (cr >> 3) * 16 + tc * 16) = *(const u32x4*)(Zt + (size_t)(c0 + cr) * NTOK + tok0 + tc * 8); }
    __builtin_amdgcn_wave_barrier();
#pragma unroll
    for (int i = 0; i < 8; ++i) { const int tk = (lane >> 3) + 8 * i, cc = lane & 7;
      const LAS u16* s = (const LAS u16*)(scr + (cc * 8) * 144 + cc * 16 + tk * 2);
      u32x4 o;
      o.x = (unsigned)s[0] | ((unsigned)s[72] << 16); o.y = (unsigned)s[144] | ((unsigned)s[216] << 16);
      o.z = (unsigned)s[288] | ((unsigned)s[360] << 16); o.w = (unsigned)s[432] | ((unsigned)s[504] << 16);
      *(u32x4*)(Z + (size_t)(tok0 + tk) * 2048 + c0 + cc * 8) = o; }
    __builtin_amdgcn_wave_barrier();
  }
}

#define GS() do { ep += gridDim.x; gsync(bar, ep, wv); } while (0)
__global__ void __launch_bounds__(512, 2) fwd_megakernel(Params p) {
  extern __shared__ __attribute__((aligned(16))) unsigned char shm[];
  LAS unsigned char* lds = (LAS unsigned char*)shm;
  const int wv = __builtin_amdgcn_readfirstlane((int)threadIdx.x >> 6);
  cg::this_grid().sync();
  unsigned char* ws = p.ws;
  unsigned* bar = (unsigned*)ws; unsigned ep = 0;
  const int bid = blockIdx.x;
  u16* Qb = (u16*)p.out; u16* Pb = (u16*)((unsigned char*)p.out + 64 * MB);
  float* gate = (float*)(ws + WS_GATE);

  phase0(p, lds, wv);
  GS();
  phase1(p, lds, wv);
  GS();
  { EpiL0Main E; E.Q = Qb; E.K = (u16*)(ws + WS_K); E.P = Pb; E.G = (u16*)(ws + WS_G); E.rope = (const float*)(ws + WS_ROPE); E.kpart = (unsigned*)(ws + WS_KPART);
    run_gemm(wv, lds, (const u16*)(ws + WS_H), 1024, (const u16*)(ws + WS_WA), 1024, NTOK, 5120, 1024, 0, E);
#ifdef REP_G0
    run_gemm(wv, lds, (const u16*)(ws + WS_H), 1024, (const u16*)(ws + WS_WA), 1024, NTOK, 5120, 1024, 0, E);
#endif
  }
  { EpiVt E; E.Vt = (u16*)(ws + WS_VT); E.shift = 11; E.toff = CTXL;
    run_gemm(wv, lds, (const u16*)(ws + WS_WA) + (size_t)5120 * 1024, 1024, (const u16*)(ws + WS_H), 1024, 1024, NTOK, 1024, 0, E); }
  { EpiCtxK E; E.K = (u16*)(ws + WS_K); E.kpart = (unsigned*)(ws + WS_KPART);
    run_gemm(wv, lds, (const u16*)(ws + WS_HC), 1024, (const u16*)(ws + WS_WA) + (size_t)1024 * 1024, 1024, NCTX, 1024, 1024, 0, E); }
  { EpiVt E; E.Vt = (u16*)(ws + WS_VT); E.shift = 8; E.toff = 0;
    run_gemm(wv, lds, (const u16*)(ws + WS_WA) + (size_t)5120 * 1024, 1024, (const u16*)(ws + WS_HC), 1024, 1024, NCTX, 1024, 192, E); }
  GS();
  pool_means(p, wv);
#ifdef REP_ATT
  attention_phase(p, lds, wv, true);
#endif
  attention_phase(p, lds, wv);
  GS();
#pragma unroll
  for (int g = 0; g < 4; ++g) { EpiPool E; E.G = (u16*)(ws + WS_G); E.pscale = p.in[I_POOLS]; E.grp = g;
    run_gemm(wv, lds, (const u16*)(ws + WS_H) + g * 256, 1024, (const u16*)(ws + WS_PW) + g * 65536, 256, NTOK, 256, 256, (g & 1) * 128, E); }
  GS();
  { EpiResid E; E.src = p.in[I_X]; E.dst = p.out; E.gate = gate;
    run_gemm(wv, lds, (const u16*)(ws + WS_G), 2048, (const u16*)(ws + WS_WAO), 2048, NTOK, 1024, 2048, 0, E); }
  GS();
  {
    const int lane = lane_id(), wave = wv;
    LAS float* gs = (LAS float*)lds; LAS float* sh = gs + 1024;
    const int b = bid >> 4;
    mod_vectors(p, wv, 1, b, gs, sh, (bid & 15) == 0 ? gate + 16384 + b * 1024 : nullptr);
    __syncthreads();
    for (int i = 0; i < 16; ++i) { const int row = bid * 128 + wave * 16 + i; mod_row(p.out + (size_t)row * 1024, (u16*)(ws + WS_H) + (size_t)row * 1024, gs, sh, lane); }
    __syncthreads();
  }
  GS();
  for (int grp = 0; grp < 4; ++grp) {
    { EpiPlain E; E.O = (u16*)(ws + WS_UT); E.ldc = NTOK;
      run_gemm(wv, lds, (const u16*)(ws + WS_WH) + (size_t)grp * 2048 * 1024, 1024, (const u16*)(ws + WS_H), 1024, 2048, NTOK, 1024, 0, E);
#ifdef REP_G1
      run_gemm(wv, lds, (const u16*)(ws + WS_WH) + (size_t)grp * 2048 * 1024, 1024, (const u16*)(ws + WS_H), 1024, 2048, NTOK, 1024, 0, E);
#endif
    }
    GS();
    conv_phase(p, lds, grp, wv);
#ifdef REP_CONV
    conv_phase(p, lds, grp, wv);
#endif
    GS();
  }
  transpose_phase(p, lds, wv);
  GS();
  { EpiResid E; E.src = p.out; E.dst = p.out; E.gate = gate + 16384;
    run_gemm(wv, lds, (const u16*)(ws + WS_Z), 2048, (const u16*)(ws + WS_WHO), 2048, NTOK, 1024, 2048, 0, E); }
  GS();
  const int lane = lane_id(), wave = wv;
  for (int i = 0; i < 16; ++i) {
    const int row = bid * 128 + wave * 16 + i; float* xr = p.out + (size_t)row * 1024;
    f32x4 v[4]; float ss = 0.f;
#pragma unroll
    for (int j = 0; j < 4; ++j) { v[j] = *(const f32x4*)(xr + 4 * lane + 256 * j); ss += (v[j][0] * v[j][0] + v[j][1] * v[j][1]) + (v[j][2] * v[j][2] + v[j][3] * v[j][3]); }
    const float rstd = rsqrtf(wave_sum(ss) * (1.f / 1024.f) + 1e-6f);
#pragma unroll
    for (int j = 0; j < 4; ++j) { const f32x4 g4 = *(const f32x4*)(p.in[I_FINALG] + 4 * lane + 256 * j); *(f32x4*)(xr + 4 * lane + 256 * j) = v[j] * rstd * g4; }
  }
}

constexpr int LDS_BYTES = 148480;

extern "C" void kernel_launch(void* const* d_in, const int* in_sizes, int n_in, void* d_out, int out_size, void* d_ws, size_t ws_size, hipStream_t stream) {
  static int grid_blocks = 0;
  if (grid_blocks == 0) {
    if (n_in != 32 || out_size != NTOK * DM || ws_size < WS_END) { fprintf(stderr, "kernel_launch: unexpected shapes (n_in %d out %d ws %zu)\n", n_in, out_size, ws_size); grid_blocks = -1; return; }
    int dev = 0, cus = 0, per_cu = 0;
    hipGetDevice(&dev);
    hipDeviceGetAttribute(&cus, hipDeviceAttributeMultiprocessorCount, dev);
    if (hipFuncSetAttribute((const void*)fwd_megakernel, hipFuncAttributeMaxDynamicSharedMemorySize, LDS_BYTES) != hipSuccess) { fprintf(stderr, "hipFuncSetAttribute failed\n"); grid_blocks = -1; return; }
    hipOccupancyMaxActiveBlocksPerMultiprocessor(&per_cu, (const void*)fwd_megakernel, 512, LDS_BYTES);
    if (per_cu < 1 || cus < 256) { fprintf(stderr, "occupancy %d cus %d\n", per_cu, cus); grid_blocks = -1; return; }
    grid_blocks = 256;
  }
  if (grid_blocks < 0) return;
  if (hipMemsetAsync(d_ws, 0, WS_KPART + 8192, stream) != hipSuccess) { fprintf(stderr, "memset failed\n"); return; }
  Params p{};
  for (int i = 0; i < 32; ++i) p.in[i] = (const float*)d_in[i];
  p.out = (float*)d_out; p.ws = (unsigned char*)d_ws;
  void* args[] = {&p};
  hipError_t e = hipLaunchCooperativeKernel((void*)fwd_megakernel, dim3(grid_blocks), dim3(512), args, LDS_BYTES, stream);
  if (e != hipSuccess) fprintf(stderr, "cooperative launch failed: %s\n", hipGetErrorString(e));
}
```

```cpp
#include <hip/hip_runtime.h>
#include <hip/hip_cooperative_groups.h>
#include <cstdio>
#include <cstdint>
namespace cg = cooperative_groups;

#define DI __device__ __forceinline__
#define LAS __attribute__((address_space(3)))
typedef unsigned short u16;
typedef short bf16x8 __attribute__((ext_vector_type(8)));
typedef float f32x4 __attribute__((ext_vector_type(4)));
typedef float f32x2 __attribute__((ext_vector_type(2)));
typedef float f32x16 __attribute__((ext_vector_type(16)));
typedef unsigned u32x4 __attribute__((ext_vector_type(4)));
typedef unsigned u32x2 __attribute__((ext_vector_type(2)));
typedef __bf16 bf16x2_t __attribute__((ext_vector_type(2)));

DI unsigned pk2(float lo, float hi) { bf16x2_t v = __builtin_convertvector((f32x2){lo, hi}, bf16x2_t); return __builtin_bit_cast(unsigned, v); }
DI float bflo(unsigned w) { return __uint_as_float(w << 16); }
DI float bfhi(unsigned w) { return __uint_as_float(w & 0xffff0000u); }
DI float bf1(u16 h) { return __uint_as_float(((unsigned)h) << 16); }
DI float silu_f(float v) { return v * __builtin_amdgcn_rcpf(1.f + __builtin_amdgcn_exp2f(-1.4426950408889634f * v)); }
template <int M> DI float swz_xor(float v) { return __int_as_float(__builtin_amdgcn_ds_swizzle(__float_as_int(v), 0x1f | (M << 10))); }
DI float wave_sum(float v) {
  v += swz_xor<1>(v); v += swz_xor<2>(v); v += swz_xor<4>(v); v += swz_xor<8>(v); v += swz_xor<16>(v);
  return __uint_as_float(__builtin_amdgcn_readlane(__float_as_uint(v), 0)) + __uint_as_float(__builtin_amdgcn_readlane(__float_as_uint(v), 32));
}
DI float bperm(int idx4, float v) { return __int_as_float(__builtin_amdgcn_ds_bpermute(idx4, __float_as_int(v))); }

DI int lane_id() { int l; asm volatile("v_mbcnt_lo_u32_b32 %0, -1, 0\n\tv_mbcnt_hi_u32_b32 %0, -1, %0" : "=v"(l)); return l; }
#define OTID(wv) ((wv) * 64 + lane_id())
DI void gsync(unsigned* bar, unsigned target, int wv) {
  __syncthreads();
  if (wv == 0 && lane_id() == 0) {
    __hip_atomic_fetch_add(bar, 1u, __ATOMIC_RELEASE, __HIP_MEMORY_SCOPE_AGENT);
    while (__hip_atomic_load(bar, __ATOMIC_RELAXED, __HIP_MEMORY_SCOPE_AGENT) < target) __builtin_amdgcn_s_sleep(2);
    __builtin_amdgcn_fence(__ATOMIC_ACQUIRE, "agent");
  }
  __syncthreads();
}
constexpr int NB = 16, SEQ = 2048, DM = 1024, NTOK = NB * SEQ, CTXL = 256, NCTX = NB * CTXL, KALL = SEQ + CTXL;
constexpr size_t MB = 1024 * 1024;
constexpr size_t WS_ROPE = 4096;
constexpr size_t WS_GATE = 16384;
constexpr size_t WS_KPART = 147456;
constexpr size_t WS_ADAP = 256 * 1024;
constexpr size_t WS_H3 = 4 * MB;
constexpr size_t WS_WA = 5 * MB;
constexpr size_t WS_WAO = 17 * MB;
constexpr size_t WS_PW = 21 * MB;
constexpr size_t WS_WH = 22 * MB;
constexpr size_t WS_WHO = 38 * MB;
constexpr size_t WS_F = 42 * MB;
constexpr size_t WS_H = 74 * MB;
constexpr size_t WS_L = 138 * MB;
constexpr size_t WS_HC = WS_L;
constexpr size_t WS_K = WS_L + 8 * MB;
constexpr size_t WS_VT = WS_K + 72 * MB;
constexpr size_t WS_G = WS_VT + 72 * MB;
constexpr size_t WS_UT = WS_L;
constexpr size_t WS_ZT = WS_L + 128 * MB;
constexpr size_t WS_Z = WS_H;
constexpr size_t WS_END = 418 * MB;

struct Params { const float* in[32]; float* out; unsigned char* ws; };
enum { I_X = 0, I_C, I_CTX, I_CCTX, I_NORMG, I_ADAW, I_ADAB, I_FINALG, I_AWIN, I_LQ1, I_LK1, I_LQ2, I_LK2, I_SUBLN, I_POOLW, I_POOLS, I_AWOUT,
       I_HWIN, I_CONVW, I_CONVB, I_FW0, I_FB0, I_FF0, I_FW1, I_FB1, I_FF1, I_FW2, I_FB2, I_FF2, I_FWOUT, I_FBIAS, I_HWOUT };

namespace pg8 {
constexpr int BM = 256, BK = 64, HALF = 128, HTB = HALF * BK * 2, STAGE_BYTES = 8 * HTB, NXCD = 8, WGM = 8;
DI int lds_byte(int r, int c) { const int st = (r >> 4) * 2 + (c >> 5), rr = r & 15, cc = c & 31, ob = rr * 64 + cc * 2; return st * 1024 + (ob ^ (((ob >> 9) & 1) << 5)); }
DI void stage_rc(int b, int& R, int& C) { const int st = b / 1024, sb = b % 1024, swz = sb ^ (((sb >> 9) & 1) << 5); R = (st >> 1) * 16 + swz / 64; C = (st & 1) * 32 + (swz % 64) / 2; }
DI int perm32(int rho) { const int n = rho >> 4, i = rho & 15; return 8 * (i >> 2) + 4 * n + (i & 3); }
struct Unit { int pm, pn; };
struct Gemm { const u16* A; const u16* Bt; int M, N, K, lda, ldb; };
struct StaticOrder {
  int nM, nN, nwg, G, c;
  DI void init(int M, int N, int G_, int c_) { nM = M / BM; nN = N / BM; nwg = nM * nN; G = G_; c = c_; }
  DI bool next(int i, Unit& u) const {
    const long L = (long)i * G + c; if (L >= nwg) return false;
    int wgid = (int)L; { const int q = nwg / NXCD, r = nwg % NXCD, xcd = wgid % NXCD, off = wgid / NXCD; wgid = (xcd < r ? xcd * (q + 1) : r * (q + 1) + (xcd - r) * q) + off; }
    const int nig = WGM * nN, gid = wgid / nig, fm = gid * WGM, gsz = (nM - fm) < WGM ? (nM - fm) : WGM;
    u.pm = fm + ((wgid % nig) % gsz); u.pn = (wgid % nig) / gsz; return true;
  }
};
template <class Epi>
DI void gemm_phase(LAS unsigned char* lds, const Gemm g, const StaticOrder& S, const Epi& E, int wv) {
  const int wid = wv, lane = lane_id(), tid = wid * 64 + lane, wr = wid >> 2, wc = wid & 3, fr = lane & 15, fq = lane >> 4;
  const int K = g.K, nt = K / BK;
  unsigned voffA[2], voffB[2];
#pragma unroll
  for (int i = 0; i < 2; ++i) { int R, C; stage_rc(tid * 16 + i * 8192, R, C); const int Rb = Epi::PERM ? ((R & ~31) + perm32(R & 31)) : R;
    voffA[i] = (unsigned)(R * g.lda + C) * 2u; voffB[i] = (unsigned)(Rb * g.ldb + C) * 2u; }
  const size_t kstep = (size_t)(BK * 2);
  const size_t hstepA = (size_t)HALF * g.lda * 2, hstepB = (size_t)HALF * g.ldb * 2;
  const size_t tstepA = 2 * hstepA, tstepB = 2 * hstepB;
  const unsigned ldsw = (unsigned)wid * 1024u;
  const int aoff = lds_byte(wr * 64 + fr, fq * 8), boff = lds_byte(wc * 32 + fr, fq * 8);
#define PG8_SA(b, h) (((b) * 2 + (h)) * HTB)
#define PG8_SB(b, h) ((4 + (b) * 2 + (h)) * HTB)
#define PG8_STAGE(bufoff, gbase, voff) do { _Pragma("unroll") for (int _i = 0; _i < 2; ++_i) \
    __builtin_amdgcn_global_load_lds((const unsigned*)((const char*)(gbase) + (voff)[_i]), (LAS unsigned*)(lds + (bufoff) + ldsw + _i * 8192), 16, 0, 0); } while (0)
#define PG8_LDA(dst, b, h) do { _Pragma("unroll") for (int m = 0; m < 4; ++m) _Pragma("unroll") for (int k = 0; k < 2; ++k) dst[m][k] = *(const LAS bf16x8*)(lds + PG8_SA(b, h) + aoff + m * 2048 + k * 1024); } while (0)
#define PG8_LDB(dst, b, h) do { _Pragma("unroll") for (int n = 0; n < 2; ++n) _Pragma("unroll") for (int k = 0; k < 2; ++k) dst[n][k] = *(const LAS bf16x8*)(lds + PG8_SB(b, h) + boff + n * 2048 + k * 1024); } while (0)
#define PG8_MMA(ai, bj, At, Bt) do { __builtin_amdgcn_s_setprio(1); _Pragma("unroll") for (int m = 0; m < 4; ++m) _Pragma("unroll") for (int n = 0; n < 2; ++n) _Pragma("unroll") for (int k = 0; k < 2; ++k) \
    acc[ai][bj][m][n] = __builtin_amdgcn_mfma_f32_16x16x32_bf16(Bt[n][k], At[m][k], acc[ai][bj][m][n], 0, 0, 0); __builtin_amdgcn_s_setprio(0); } while (0)
#define PG8_WAIT_V(n) asm volatile("s_waitcnt vmcnt(" #n ")" ::: "memory")
#define PG8_WAIT_L(n) asm volatile("s_waitcnt lgkmcnt(" #n ")" ::: "memory")
#define PG8_BAR __builtin_amdgcn_s_barrier()
#define PG8_SCHED __builtin_amdgcn_sched_barrier(0)
  Unit cur, nxt; int ui = 0;
  if (!S.next(0, cur)) return;
  f32x4 acc[2][2][4][2];
#pragma unroll
  for (int a = 0; a < 2; ++a)
#pragma unroll
    for (int b = 0; b < 2; ++b)
#pragma unroll
      for (int m = 0; m < 4; ++m)
#pragma unroll
        for (int n = 0; n < 2; ++n) acc[a][b][m][n] = (f32x4){0.f, 0.f, 0.f, 0.f};
  bf16x8 At[4][2], B0[2][2], B1[2][2];
  const char* cA = (const char*)g.A + (size_t)cur.pm * tstepA; const char* cB = (const char*)g.Bt + (size_t)cur.pn * tstepB;
  PG8_STAGE(PG8_SB(0, 0), cB, voffB); PG8_STAGE(PG8_SA(0, 0), cA, voffA); PG8_STAGE(PG8_SB(0, 1), cB + hstepB, voffB); PG8_STAGE(PG8_SA(0, 1), cA + hstepA, voffA);
  if (wr == 1) PG8_BAR;
  PG8_WAIT_V(4); PG8_BAR;
  PG8_STAGE(PG8_SB(1, 0), cB + kstep, voffB); PG8_STAGE(PG8_SA(1, 0), cA + kstep, voffA); PG8_STAGE(PG8_SB(1, 1), cB + hstepB + kstep, voffB);
  PG8_WAIT_V(6); PG8_BAR;
  for (;;) {
    const bool has_next = S.next(ui + 1, nxt);
    const char* nA = has_next ? (const char*)g.A + (size_t)nxt.pm * tstepA : cA; const char* nB = has_next ? (const char*)g.Bt + (size_t)nxt.pn * tstepB : cB;
    for (int t = 0; t < nt; t += 2) {
      const bool last = (t == nt - 2);
      const char* a1 = cA + (size_t)(t + 1) * kstep;
      const char* a2 = last ? nA : cA + (size_t)(t + 2) * kstep; const char* b2 = last ? nB : cB + (size_t)(t + 2) * kstep;
      const char* a3 = a2 + kstep; const char* b3 = b2 + kstep;
      PG8_LDB(B0, 0, 0); PG8_SCHED; PG8_LDA(At, 0, 0); PG8_STAGE(PG8_SA(1, 1), a1 + hstepA, voffA);
      PG8_WAIT_L(8); PG8_BAR; PG8_WAIT_L(0); PG8_MMA(0, 0, At, B0); PG8_BAR; PG8_SCHED;
      PG8_LDB(B1, 0, 1); PG8_STAGE(PG8_SB(0, 0), b2, voffB);
      PG8_BAR; PG8_WAIT_L(0); PG8_MMA(0, 1, At, B1); PG8_BAR;
      PG8_LDA(At, 0, 1); PG8_STAGE(PG8_SA(0, 0), a2, voffA);
      PG8_BAR; PG8_WAIT_L(0); PG8_MMA(1, 0, At, B0); PG8_BAR; PG8_SCHED;
      PG8_STAGE(PG8_SB(0, 1), b2 + hstepB, voffB);
      PG8_WAIT_V(6); PG8_BAR; PG8_MMA(1, 1, At, B1); PG8_BAR;
      PG8_LDB(B0, 1, 0); PG8_SCHED; PG8_LDA(At, 1, 0); PG8_STAGE(PG8_SA(0, 1), a2 + hstepA, voffA);
      PG8_WAIT_L(8); PG8_BAR; PG8_WAIT_L(0); PG8_MMA(0, 0, At, B0); PG8_BAR; PG8_SCHED;
      PG8_LDB(B1, 1, 1); PG8_STAGE(PG8_SB(1, 0), b3, voffB);
      PG8_BAR; PG8_WAIT_L(0); PG8_MMA(0, 1, At, B1); PG8_BAR;
      PG8_LDA(At, 1, 1); PG8_STAGE(PG8_SA(1, 0), a3, voffA);
      PG8_BAR; PG8_WAIT_L(0); PG8_MMA(1, 0, At, B0); PG8_BAR; PG8_SCHED;
      PG8_STAGE(PG8_SB(1, 1), b3 + hstepB, voffB);
      PG8_WAIT_V(6); PG8_BAR; PG8_MMA(1, 1, At, B1); PG8_BAR;
    }
    E(acc, cur, wr, wc, fr, fq);
    if (!has_next) break;
#pragma unroll
    for (int a = 0; a < 2; ++a)
#pragma unroll
      for (int b = 0; b < 2; ++b)
#pragma unroll
        for (int m = 0; m < 4; ++m)
#pragma unroll
          for (int n = 0; n < 2; ++n) acc[a][b][m][n] = (f32x4){0.f, 0.f, 0.f, 0.f};
    cur = nxt; cA = nA; cB = nB; ++ui;
  }
  PG8_WAIT_V(0);
  if (wr == 0) PG8_BAR;
  PG8_BAR;
#undef PG8_SA
#undef PG8_SB
#undef PG8_STAGE
#undef PG8_LDA
#undef PG8_LDB
#undef PG8_MMA
#undef PG8_WAIT_V
#undef PG8_WAIT_L
#undef PG8_BAR
#undef PG8_SCHED
}
}
using pg8::Unit;
typedef f32x4 AccT[2][2][4][2];

DI u32x4 pack8(const f32x4& a, const f32x4& b) { u32x4 w; w.x = pk2(a[0], a[1]); w.y = pk2(a[2], a[3]); w.z = pk2(b[0], b[1]); w.w = pk2(b[2], b[3]); return w; }

struct EpiL0Main {
  static constexpr bool PERM = true;
  u16 *Q, *K, *P, *G; const float* rope; unsigned* kpart;
  DI void operator()(const AccT& acc, const Unit& u, int wr, int wc, int fr, int fq) const {
    const int pn = u.pn, row0 = u.pm * 256 + wr * 64 + fr;
    if (pn < 8) {
      const bool isq = pn < 4;
      const float sc = isq ? 0.125f * 1.4426950408889634f : 1.f;
      const int half = wc & 1, hi = fq >> 1, jj0 = 8 * (fq & 1), px = ((fq * 16 + fr) ^ 32) * 4;
      float nmax[2] = {0.f, 0.f};
#pragma unroll
      for (int ai = 0; ai < 2; ++ai)
#pragma unroll
        for (int m = 0; m < 4; ++m) {
          const int row = row0 + ai * 128 + m * 16, t = row & 2047, b = row >> 11;
          const int pos = half ? (t & 63) : (t >> 6);
          const f32x4 c0 = *(const f32x4*)(rope + pos * 16 + jj0), c1 = *(const f32x4*)(rope + pos * 16 + jj0 + 4);
          const f32x4 s0 = *(const f32x4*)(rope + 1024 + pos * 16 + jj0), s1 = *(const f32x4*)(rope + 1024 + pos * 16 + jj0 + 4);
#pragma unroll
          for (int bj = 0; bj < 2; ++bj) {
            f32x4 v0 = acc[ai][bj][m][0], v1 = acc[ai][bj][m][1], p0, p1;
#pragma unroll
            for (int e = 0; e < 4; ++e) { p0[e] = bperm(px, v0[e]); p1[e] = bperm(px, v1[e]); }
            f32x4 o0, o1;
            if (hi) { o0 = v0 * c0 + p0 * s0; o1 = v1 * c1 + p1 * s1; } else { o0 = v0 * c0 - p0 * s0; o1 = v1 * c1 - p1 * s1; }
            o0 *= sc; o1 *= sc;
            nmax[bj] = fmaxf(nmax[bj], (o0[0] * o0[0] + o0[1] * o0[1]) + (o0[2] * o0[2] + o0[3] * o0[3]) + (o1[0] * o1[0] + o1[1] * o1[1]) + (o1[2] * o1[2] + o1[3] * o1[3]));
            const int col = (pn & 3) * 256 + bj * 128 + wc * 32 + 8 * fq, sh = col >> 6, d = col & 63;
            u16* dst = isq ? Q + ((size_t)(b * 16 + sh) * SEQ + t) * 64 + d : K + ((size_t)(b * 16 + sh) * KALL + CTXL + t) * 64 + d;
            *(u32x4*)dst = pack8(o0, o1);
          }
        }
      if (!isq) {
        const int b = (u.pm * 256) >> 11;
#pragma unroll
        for (int bj = 0; bj < 2; ++bj) { const int sh = ((pn & 3) * 256 + bj * 128 + wc * 32) >> 6;
          atomicMax(kpart + (b * 16 + sh) * 8 + (wc & 1) * 4 + fq, __float_as_uint(nmax[bj] * 1.02f)); }
      }
    } else if (pn < 12) {
#pragma unroll
      for (int ai = 0; ai < 2; ++ai)
#pragma unroll
        for (int m = 0; m < 4; ++m) {
          const int row = row0 + ai * 128 + m * 16;
#pragma unroll
          for (int bj = 0; bj < 2; ++bj) {
            const int col = (pn - 8) * 256 + bj * 128 + wc * 32 + 8 * fq;
            *(u32x4*)(P + (size_t)row * 1024 + col) = pack8(acc[ai][bj][m][0], acc[ai][bj][m][1]);
          }
        }
    } else {
#pragma unroll
      for (int ai = 0; ai < 2; ++ai)
#pragma unroll
        for (int m = 0; m < 4; ++m) {
          const int row = row0 + ai * 128 + m * 16;
#pragma unroll
          for (int bj = 0; bj < 2; ++bj) {
            const int col = (pn - 12) * 256 + bj * 128 + wc * 32 + 8 * fq;
            f32x4 v0 = acc[ai][bj][m][0], v1 = acc[ai][bj][m][1];
#pragma unroll
            for (int e = 0; e < 4; ++e) { v0[e] = silu_f(v0[e]); v1[e] = silu_f(v1[e]); }
            *(u32x4*)(G + (size_t)row * 2048 + col) = pack8(v0, v1);
          }
        }
    }
  }
};
struct EpiVt {
  static constexpr bool PERM = true;
  u16* Vt; int shift, toff;
  DI void operator()(const AccT& acc, const Unit& u, int wr, int wc, int fr, int fq) const {
    const int f0 = u.pm * 256 + wr * 64 + fr;
#pragma unroll
    for (int ai = 0; ai < 2; ++ai)
#pragma unroll
      for (int m = 0; m < 4; ++m) {
        const int f = f0 + ai * 128 + m * 16;
#pragma unroll
        for (int bj = 0; bj < 2; ++bj) {
          const int tok = u.pn * 256 + bj * 128 + wc * 32 + 8 * fq, b = tok >> shift, t = tok & ((1 << shift) - 1);
          *(u32x4*)(Vt + ((size_t)(b * 8 + (f >> 7)) * 128 + (f & 127)) * KALL + toff + t) = pack8(acc[ai][bj][m][0], acc[ai][bj][m][1]);
        }
      }
  }
};
struct EpiCtxK {
  static constexpr bool PERM = true;
  u16* K; unsigned* kpart;
  DI void operator()(const AccT& acc, const Unit& u, int wr, int wc, int fr, int fq) const {
    const int row0 = u.pm * 256 + wr * 64 + fr;
    float nmax[2] = {0.f, 0.f};
#pragma unroll
    for (int ai = 0; ai < 2; ++ai)
#pragma unroll
      for (int m = 0; m < 4; ++m) {
        const int row = row0 + ai * 128 + m * 16, b = row >> 8, t = row & 255;
#pragma unroll
        for (int bj = 0; bj < 2; ++bj) {
          const int col = u.pn * 256 + bj * 128 + wc * 32 + 8 * fq, sh = col >> 6, d = col & 63;
          const f32x4 o0 = acc[ai][bj][m][0], o1 = acc[ai][bj][m][1];
          nmax[bj] = fmaxf(nmax[bj], (o0[0] * o0[0] + o0[1] * o0[1]) + (o0[2] * o0[2] + o0[3] * o0[3]) + (o1[0] * o1[0] + o1[1] * o1[1]) + (o1[2] * o1[2] + o1[3] * o1[3]));
          *(u32x4*)(K + ((size_t)(b * 16 + sh) * KALL + t) * 64 + d) = pack8(o0, o1);
        }
      }
    const int b = u.pm;
#pragma unroll
    for (int bj = 0; bj < 2; ++bj) { const int sh = (u.pn * 256 + bj * 128 + wc * 32) >> 6;
      atomicMax(kpart + (b * 16 + sh) * 8 + (wc & 1) * 4 + fq, __float_as_uint(nmax[bj] * 1.02f)); }
  }
};
struct EpiPool {
  static constexpr bool PERM = true;
  u16* G; const float* pscale; int grp;
  DI void operator()(const AccT& acc, const Unit& u, int wr, int wc, int fr, int fq) const {
    const int row0 = u.pm * 256 + wr * 64 + fr;
#pragma unroll
    for (int bj = 0; bj < 2; ++bj) {
      const int col = grp * 256 + bj * 128 + wc * 32 + 8 * fq;
      const f32x4 ps0 = *(const f32x4*)(pscale + col), ps1 = *(const f32x4*)(pscale + col + 4);
#pragma unroll
      for (int ai = 0; ai < 2; ++ai)
#pragma unroll
        for (int m = 0; m < 4; ++m) {
          const int row = row0 + ai * 128 + m * 16;
          u16* p = G + (size_t)row * 2048 + 1024 + col;
          const u32x4 gv = *(const u32x4*)p;
          f32x4 g0 = {bflo(gv.x), bfhi(gv.x), bflo(gv.y), bfhi(gv.y)}, g1 = {bflo(gv.z), bfhi(gv.z), bflo(gv.w), bfhi(gv.w)};
          *(u32x4*)p = pack8(acc[ai][bj][m][0] * ps0 * g0, acc[ai][bj][m][1] * ps1 * g1);
        }
    }
  }
};
struct EpiResid {
  static constexpr bool PERM = false;
  const float* src; float* dst; const float* gate;
  DI void operator()(const AccT& acc, const Unit& u, int wr, int wc, int fr, int fq) const {
    const int row0 = u.pm * 256 + wr * 64 + fr, col0 = u.pn * 256 + wc * 32 + 4 * fq, b = (u.pm * 256) >> 11;
#pragma unroll
    for (int bj = 0; bj < 2; ++bj)
#pragma unroll
      for (int n = 0; n < 2; ++n) {
        const int col = col0 + bj * 128 + n * 16;
        const f32x4 gt = *(const f32x4*)(gate + b * 1024 + col);
#pragma unroll
        for (int ai = 0; ai < 2; ++ai)
#pragma unroll
          for (int m = 0; m < 4; ++m) {
            const size_t o = (size_t)(row0 + ai * 128 + m * 16) * 1024 + col;
            *(f32x4*)(dst + o) = *(const f32x4*)(src + o) + gt * acc[ai][bj][m][n];
          }
      }
  }
};
struct EpiPlain {
  static constexpr bool PERM = true;
  u16* O; int ldc;
  DI void operator()(const AccT& acc, const Unit& u, int wr, int wc, int fr, int fq) const {
    const int row0 = u.pm * 256 + wr * 64 + fr, col0 = u.pn * 256 + wc * 32 + 8 * fq;
#pragma unroll
    for (int ai = 0; ai < 2; ++ai)
#pragma unroll
      for (int m = 0; m < 4; ++m)
#pragma unroll
        for (int bj = 0; bj < 2; ++bj)
          *(u32x4*)(O + (size_t)(row0 + ai * 128 + m * 16) * ldc + col0 + bj * 128) = pack8(acc[ai][bj][m][0], acc[ai][bj][m][1]);
  }
};

template <class Epi>
DI void run_gemm(int wv, LAS unsigned char* lds, const u16* A, int lda, const u16* Bt, int ldb, int M, int N, int K, int coff, const Epi& E) {
  asm volatile("" : "+s"(K));
  pg8::Gemm g; g.A = A; g.Bt = Bt; g.M = M; g.N = N; g.K = K; g.lda = lda; g.ldb = ldb;
  pg8::StaticOrder S; S.init(M, N, (int)gridDim.x, (int)((blockIdx.x + coff) % gridDim.x));
  pg8::gemm_phase<Epi>(lds, g, S, E, wv);
  __syncthreads();
}

DI void tr_item(const float* W, int K, int N, u16* WT, int k0, int n0, int drow0, LAS float* scr, int lane) {
#pragma unroll
  for (int i = 0; i < 32; ++i) { const int kk = 2 * i + (lane >> 5); scr[kk * 33 + (lane & 31)] = W[(size_t)(k0 + kk) * N + n0 + (lane & 31)]; }
  __builtin_amdgcn_wave_barrier();
  const int c = lane & 7;
#pragma unroll
  for (int j = 0; j < 4; ++j) { const int n = (lane >> 3) + 8 * j; const LAS float* s = scr + (8 * c) * 33 + n;
    u32x4 o; o.x = pk2(s[0 * 33], s[1 * 33]); o.y = pk2(s[2 * 33], s[3 * 33]); o.z = pk2(s[4 * 33], s[5 * 33]); o.w = pk2(s[6 * 33], s[7 * 33]);
    *(u32x4*)(WT + (size_t)(drow0 + n) * K + k0 + 8 * c) = o; }
  __builtin_amdgcn_wave_barrier();
}

DI void phase0(const Params& p, LAS unsigned char* lds, int wv) {
  const int lane = lane_id(), wave = wv, tid = wv * 64 + lane, bid = blockIdx.x, G = gridDim.x;
  unsigned char* ws = p.ws;
  {
    LAS float* sc = (LAS float*)lds;
    for (int item = bid; item < 96; item += G) {
      const int l = item / 48, r2 = item % 48, ks = r2 / 6, cb = r2 % 6;
      __syncthreads();
      for (int i = tid; i < 17 * 128; i += 512) { const int rr = i >> 7, k = ks * 128 + (i & 127); const float cv = rr < 16 ? p.in[I_C][rr * 1024 + k] : p.in[I_CCTX][k]; sc[i] = silu_f(cv); }
      __syncthreads();
      const int j = cb * 512 + tid;
      float a[17];
#pragma unroll
      for (int rr = 0; rr < 17; ++rr) a[rr] = 0.f;
      const float* W = p.in[I_ADAW] + (size_t)l * 1024 * 3072 + (size_t)(ks * 128) * 3072 + j;
#pragma unroll 16
      for (int kk = 0; kk < 128; ++kk) { const float w = W[(size_t)kk * 3072];
#pragma unroll
        for (int rr = 0; rr < 17; ++rr) a[rr] += sc[rr * 128 + kk] * w; }
      float* o = (float*)(ws + WS_ADAP) + (size_t)((l * 8 + ks) * 17) * 3072 + j;
#pragma unroll
      for (int rr = 0; rr < 17; ++rr) o[(size_t)rr * 3072] = a[rr];
    }
    __syncthreads();
  }
  if (bid == G - 1) {
    float* rope = (float*)(ws + WS_ROPE);
    for (int i = tid; i < 1024; i += 512) { const int pos = i >> 4, jj = i & 15; const float inv = powf(10000.f, -(float)jj / 16.f), ang = (float)pos * inv; rope[i] = cosf(ang); rope[1024 + i] = sinf(ang); }
  }
  {
    LAS float* mw = (LAS float*)(lds + 71680);
    __syncthreads();
#pragma unroll
    for (int q = 0; q < 5; ++q) { const int i = tid + 512 * q; if (i < 2112) mw[i] = p.in[I_FW0][i]; }
#pragma unroll
    for (int q = 0; q < 8; ++q) { const int i = tid + 512 * q; mw[2112 + i] = p.in[I_FW1][i]; mw[6208 + i] = p.in[I_FW2][i]; }
    __syncthreads();
    for (int t = bid * 8 + wave; t < SEQ; t += G * 8) {
      const float tl = (float)t / 2047.f, w = 6.283185307179586f * (float)t / 2048.f;
      float zv = 0.f;
      if (lane == 0) zv = tl;
      else if (lane < 33) { const int i = (lane - 1) & 15; const float band = 1e-4f + (float)i * ((15.f - 1e-4f) / 15.f); zv = lane < 17 ? cosf(band * w) : -sinf(band * w); }
      float a = 0.f;
#pragma unroll
      for (int i = 0; i < 33; ++i) a += __uint_as_float(__builtin_amdgcn_readlane(__float_as_uint(zv), i)) * mw[i * 64 + lane];
      float h = sinf(p.in[I_FF0][lane] * (a + p.in[I_FB0][lane]));
      a = 0.f;
#pragma unroll
      for (int i = 0; i < 64; ++i) a += __uint_as_float(__builtin_amdgcn_readlane(__float_as_uint(h), i)) * mw[2112 + i * 64 + lane];
      h = sinf(p.in[I_FF1][lane] * (a + p.in[I_FB1][lane]));
      a = 0.f;
#pragma unroll
      for (int i = 0; i < 64; ++i) a += __uint_as_float(__builtin_amdgcn_readlane(__float_as_uint(h), i)) * mw[6208 + i * 64 + lane];
      h = sinf(p.in[I_FF2][lane] * (a + p.in[I_FB2][lane]));
      ((float*)(ws + WS_H3))[t * 64 + lane] = h;
    }
  }
  {
    u16* WPB = (u16*)(ws + WS_G);
    for (int i = bid * 512 + tid; i < 1024 * 256; i += G * 512) { const int k = i >> 8, c4 = i & 255;
      const f32x4 v = *(const f32x4*)(p.in[I_AWIN] + (size_t)k * 6144 + 3072 + c4 * 4);
      u32x2 w; w.x = pk2(v[0], v[1]); w.y = pk2(v[2], v[3]);
      *(u32x2*)(WPB + (size_t)k * 1024 + c4 * 4) = w; }
  }
  {
    LAS float* scr = (LAS float*)lds + wave * (64 * 33);
    constexpr int I_A = 16 * 192, I_AO = 32 * 32, I_P = 128, I_H = 16 * 256, I_HO = 32 * 32, NIT = I_A + I_AO + I_P + I_H + I_HO;
    for (int it = bid * 8 + wave; it < NIT; it += G * 8) {
      int r = it;
      if (r < I_A) { const int kb = r / 192, nb = r % 192, n0 = nb * 32; const int drow = n0 < 2048 ? n0 : (n0 < 3072 ? n0 + 3072 : n0 - 1024);
        tr_item(p.in[I_AWIN], 1024, 6144, (u16*)(ws + WS_WA), kb * 64, n0, drow, scr, lane); continue; } r -= I_A;
      if (r < I_AO) { const int kb = r / 32, nb = r % 32; tr_item(p.in[I_AWOUT], 2048, 1024, (u16*)(ws + WS_WAO), kb * 64, nb * 32, nb * 32, scr, lane); continue; } r -= I_AO;
      if (r < I_P) { const int g = r / 32, q = r % 32, kb = q / 8, nb = q % 8; tr_item(p.in[I_POOLW] + g * 65536, 256, 256, (u16*)(ws + WS_PW) + g * 65536, kb * 64, nb * 32, nb * 32, scr, lane); continue; } r -= I_P;
      if (r < I_H) { const int kb = r / 256, nb = r % 256, n0 = nb * 32; const int part = n0 >> 11, c = n0 & 2047; const int drow = (c >> 9) * 2048 + part * 512 + (c & 511);
        tr_item(p.in[I_HWIN], 1024, 8192, (u16*)(ws + WS_WH), kb * 64, n0, drow, scr, lane); continue; } r -= I_H;
      { const int kb = r / 32, nb = r % 32; tr_item(p.in[I_HWOUT], 2048, 1024, (u16*)(ws + WS_WHO), kb * 64, nb * 32, nb * 32, scr, lane); }
    }
  }
}

DI void mod_vectors(const Params& p, int wv, int l, int r, LAS float* gs, LAS float* sh, float* gate_out) {
  const float* adaP = (const float*)(p.ws + WS_ADAP);
  for (int j = OTID(wv); j < 1024; j += 512) {
    float s0 = p.in[I_ADAB][l * 3072 + j], s1 = p.in[I_ADAB][l * 3072 + 1024 + j], s2 = p.in[I_ADAB][l * 3072 + 2048 + j];
#pragma unroll
    for (int ks = 0; ks < 8; ++ks) { const float* a = adaP + (size_t)((l * 8 + ks) * 17 + r) * 3072 + j; s0 += a[0]; s1 += a[1024]; s2 += a[2048]; }
    sh[j] = s0; gs[j] = p.in[I_NORMG][l * 1024 + j] * (1.f + s1);
    if (gate_out) gate_out[j] = s2;
  }
}
DI void mod_row(const float* xrow, u16* orow, const LAS float* gs, const LAS float* sh, int lane) {
  f32x4 v[4]; float ss = 0.f;
#pragma unroll
  for (int j = 0; j < 4; ++j) { v[j] = *(const f32x4*)(xrow + 4 * lane + 256 * j); ss += (v[j][0] * v[j][0] + v[j][1] * v[j][1]) + (v[j][2] * v[j][2] + v[j][3] * v[j][3]); }
  const float rstd = rsqrtf(wave_sum(ss) * (1.f / 1024.f) + 1e-6f);
#pragma unroll
  for (int j = 0; j < 4; ++j) {
    const int c = 4 * lane + 256 * j;
    const f32x4 g4 = *(const LAS f32x4*)(gs + c), s4 = *(const LAS f32x4*)(sh + c);
    const f32x4 o = v[j] * rstd * g4 + s4;
    u32x2 w; w.x = pk2(o[0], o[1]); w.y = pk2(o[2], o[3]);
    *(u32x2*)(orow + c) = w;
  }
}

DI void phase1(const Params& p, LAS unsigned char* lds, int wv) {
  const int lane = lane_id(), wave = wv, tid = wv * 64 + lane, bid = blockIdx.x, G = gridDim.x;
  unsigned char* ws = p.ws;
  {
    const float* H3 = (const float*)(ws + WS_H3);
    const float* wout = p.in[I_FWOUT];
    u16* F = (u16*)(ws + WS_F);
    const float mind = -3.0701134573253945f, maxd = -15.350567286626973f;
    LAS float* Hs = (LAS float*)lds;
    LAS float* Wl = (LAS float*)(lds + 16384) + wave * 2048;
    for (int it = bid; it < 1024; it += G) {
      const int tb = it & 31, cs = it >> 5, t = tb * 64 + lane, colb = cs * 256 + wave * 32, dir = (colb >> 11) & 1, o = colb >> 12;
      __syncthreads();
#pragma unroll
      for (int q = 0; q < 2; ++q) { const int idx = tid + 512 * q, tt = idx >> 4, j4 = idx & 15;
        const f32x4 h4 = *(const f32x4*)(H3 + (size_t)(tb * 64 + tt) * 64 + j4 * 4);
        Hs[(4 * j4) * 64 + tt] = h4[0]; Hs[(4 * j4 + 1) * 64 + tt] = h4[1]; Hs[(4 * j4 + 2) * 64 + tt] = h4[2]; Hs[(4 * j4 + 3) * 64 + tt] = h4[3]; }
#pragma unroll
      for (int q = 0; q < 8; ++q) { const int j = q * 8 + (lane >> 3), c4 = lane & 7;
        *(LAS f32x4*)(Wl + j * 32 + c4 * 4) = *(const f32x4*)(wout + (size_t)j * 8192 + colb + c4 * 4); }
      __syncthreads();
      f32x4 acc[8];
#pragma unroll
      for (int c = 0; c < 8; ++c) acc[c] = (f32x4){0.f, 0.f, 0.f, 0.f};
#pragma unroll 4
      for (int j = 0; j < 64; ++j) {
        const float h = Hs[j * 64 + lane];
#pragma unroll
        for (int c = 0; c < 8; ++c) acc[c] += h * *(const LAS f32x4*)(Wl + j * 32 + c * 4);
      }
      const float tl = (float)t / 2047.f;
#pragma unroll
      for (int c = 0; c < 8; ++c)
#pragma unroll
        for (int e = 0; e < 4; ++e) {
          const int cch = (colb + c * 4 + e) & 2047;
          const float delta = fabsf(mind + (float)cch * ((maxd - mind) / 2047.f));
          const float val = acc[c][e] * expf(-tl * delta);
          u16* Fr = F + (size_t)(cch * 2 + o) * 4096;
          const int idx = dir == 0 ? 2047 - t : (t > 0 ? 2047 + t : 4095);
          Fr[idx] = (dir == 1 && t == 0) ? (u16)0 : (u16)(pk2(val, 0.f) & 0xffffu);
        }
    }
  }
  __syncthreads();
#pragma unroll 1
  for (int g = 0; g < 4; ++g) { EpiPlain E; E.O = (u16*)(ws + WS_WA) + (size_t)(2048 + g * 256) * 1024; E.ldc = 1024;
    run_gemm(wv, lds, (const u16*)(ws + WS_PW) + g * 65536, 256, (const u16*)(ws + WS_G) + g * 256, 1024, 256, 1024, 256, 256 - 4 * g, E); }
  {
    LAS float* gs = (LAS float*)lds; LAS float* sh = gs + 1024; LAS float* gsc = sh + 1024; LAS float* shc = gsc + 1024;
    const int b = bid >> 4;
    float* gate = (float*)(ws + WS_GATE);
    __syncthreads();
    mod_vectors(p, wv, 0, b, gs, sh, (bid & 15) == 0 ? gate + b * 1024 : nullptr);
    mod_vectors(p, wv, 0, 16, gsc, shc, nullptr);
    __syncthreads();
    for (int i = 0; i < 16; ++i) { const int row = bid * 128 + wave * 16 + i; mod_row(p.in[I_X] + (size_t)row * 1024, (u16*)(ws + WS_H) + (size_t)row * 1024, gs, sh, lane); }
    for (int i = 0; i < 2; ++i) { const int row = bid * 16 + wave * 2 + i; mod_row(p.in[I_CTX] + (size_t)row * 1024, (u16*)(ws + WS_HC) + (size_t)row * 1024, gsc, shc, lane); }
    __syncthreads();
  }
}

DI void pool_means(const Params& p, int wv) {
  const u16* P = (const u16*)((unsigned char*)p.out + 64 * MB);
  u16* G = (u16*)(p.ws + WS_G); const float* pscale = p.in[I_POOLS];
  for (int gid = blockIdx.x * 512 + OTID(wv); gid < NB * 64 * 128; gid += gridDim.x * 512) {
    const int ch = gid & 127, r = (gid >> 7) & 63, b = gid >> 13, gi = ch >> 5, hw = 1 << gi;
    const u16* base = P + (size_t)b * SEQ * 1024 + ch * 8;
    const int t0 = r * 32;
    const f32x4 ps0 = *(const f32x4*)(pscale + ch * 8), ps1 = *(const f32x4*)(pscale + ch * 8 + 4);
    float s[8];
#pragma unroll
    for (int e = 0; e < 8; ++e) s[e] = 0.f;
    for (int q = t0 - hw; q < t0 + hw; ++q) if (q >= 0 && q < SEQ) { const u32x4 v = *(const u32x4*)(base + (size_t)q * 1024);
      s[0] += bflo(v.x); s[1] += bfhi(v.x); s[2] += bflo(v.y); s[3] += bfhi(v.y); s[4] += bflo(v.z); s[5] += bfhi(v.z); s[6] += bflo(v.w); s[7] += bfhi(v.w); }
#pragma unroll 4
    for (int t = t0; t < t0 + 32; ++t) {
      const int lo = max(t - hw, 0), hi = min(t + hw, SEQ);
      const float inv = 1.f / (float)(hi - lo);
      const u32x4 c = *(const u32x4*)(base + (size_t)t * 1024);
      u16* gp = G + ((size_t)b * SEQ + t) * 2048 + 1024 + ch * 8;
      const u32x4 gv = *(const u32x4*)gp;
      u32x4 o;
      o.x = pk2((s[0] * inv - bflo(c.x)) * ps0[0] * bflo(gv.x), (s[1] * inv - bfhi(c.x)) * ps0[1] * bfhi(gv.x)); o.y = pk2((s[2] * inv - bflo(c.y)) * ps0[2] * bflo(gv.y), (s[3] * inv - bfhi(c.y)) * ps0[3] * bfhi(gv.y));
      o.z = pk2((s[4] * inv - bflo(c.z)) * ps1[0] * bflo(gv.z), (s[5] * inv - bfhi(c.z)) * ps1[1] * bfhi(gv.z)); o.w = pk2((s[6] * inv - bflo(c.w)) * ps1[2] * bflo(gv.w), (s[7] * inv - bfhi(c.w)) * ps1[3] * bfhi(gv.w));
      *(u32x4*)gp = o;
      if (t + hw < SEQ) { const u32x4 v = *(const u32x4*)(base + (size_t)(t + hw) * 1024);
        s[0] += bflo(v.x); s[1] += bfhi(v.x); s[2] += bflo(v.y); s[3] += bfhi(v.y); s[4] += bflo(v.z); s[5] += bfhi(v.z); s[6] += bflo(v.w); s[7] += bfhi(v.w); }
      if (t - hw >= 0) { const u32x4 v = *(const u32x4*)(base + (size_t)(t - hw) * 1024);
        s[0] -= bflo(v.x); s[1] -= bfhi(v.x); s[2] -= bflo(v.y); s[3] -= bfhi(v.y); s[4] -= bflo(v.z); s[5] -= bfhi(v.z); s[6] -= bflo(v.w); s[7] -= bfhi(v.w); }
    }
  }
}

constexpr int AT_KSTR = 144, AT_VSTR = 136, AT_K1 = 9216, AT_V = 18432, AT_STAGE = 35840;
#define MFMA32(a, b, c) __builtin_amdgcn_mfma_f32_32x32x16_bf16((a), (b), (c), 0, 0, 0)
template <bool ZS> DI void att_tile(const LAS unsigned char* st, int sub, int ql, int hh, const bf16x8 (&qf)[4], float nshift, f32x16 (&O)[4], float& l) {
  const LAS unsigned char* kb_ = st + sub * AT_K1 + ql * AT_KSTR + 16 * hh;
  const LAS unsigned char* vb_ = st + AT_V + ql * AT_VSTR + 8 * hh;
  f32x16 S[2];
#pragma unroll
  for (int kb = 0; kb < 2; ++kb) {
#pragma unroll
    for (int r = 0; r < 16; ++r) S[kb][r] = ZS ? 0.f : nshift;
#pragma unroll
    for (int ks = 0; ks < 4; ++ks) { const bf16x8 kf = *(const LAS bf16x8*)(kb_ + kb * (32 * AT_KSTR) + ks * 32); S[kb] = MFMA32(kf, qf[ks], S[kb]); }
  }
  float ps = 0.f;
#pragma unroll
  for (int kb = 0; kb < 2; ++kb)
#pragma unroll
    for (int r = 0; r < 16; ++r) { const float e = __builtin_amdgcn_exp2f(S[kb][r]); S[kb][r] = e; ps += e; }
  l += ps;
#pragma unroll
  for (int kb = 0; kb < 2; ++kb)
#pragma unroll
    for (int s2 = 0; s2 < 2; ++s2) {
      u32x4 pw; pw.x = pk2(S[kb][8 * s2], S[kb][8 * s2 + 1]); pw.y = pk2(S[kb][8 * s2 + 2], S[kb][8 * s2 + 3]); pw.z = pk2(S[kb][8 * s2 + 4], S[kb][8 * s2 + 5]); pw.w = pk2(S[kb][8 * s2 + 6], S[kb][8 * s2 + 7]);
      const bf16x8 pf = __builtin_bit_cast(bf16x8, pw);
#pragma unroll
      for (int blk = 0; blk < 4; ++blk) {
        const LAS unsigned char* va = vb_ + blk * (32 * AT_VSTR) + (32 * kb + 16 * s2) * 2;
        const u32x2 lo = *(const LAS u32x2*)va, hi = *(const LAS u32x2*)(va + 16);
        const u32x4 vw = {lo.x, lo.y, hi.x, hi.y};
        O[blk] = MFMA32(__builtin_bit_cast(bf16x8, vw), pf, O[blk]);
      }
    }
}
DI void attention_phase(const Params& p, LAS unsigned char* lds, int wv, bool dry = false) {
  const int lane = lane_id(), tid = wv * 64 + lane;
  const int sub = wv >> 2, qg = wv & 3, ql = lane & 31, hh = lane >> 5, px = (lane ^ 32) * 4;
  const u16* Qb = (const u16*)p.out; const u16* Kb = (const u16*)(p.ws + WS_K); const u16* Vtb = (const u16*)(p.ws + WS_VT); u16* G = (u16*)(p.ws + WS_G);
  float lam;
  { const float a = p.in[I_LQ1][lane] * p.in[I_LK1][lane], b2 = p.in[I_LQ2][lane] * p.in[I_LK2][lane]; lam = expf(wave_sum(a)) - expf(wave_sum(b2)) + 0.2f; }
  const int krow = tid >> 3, kc = tid & 7;
  const unsigned koff = (unsigned)(krow * 128 + kc * 16), voff = (unsigned)(krow * (KALL * 2) + kc * 16);
  for (int it = 0; it < 8; ++it) {
    const int xj = blockIdx.x >> 3, bh = it * 16 + (blockIdx.x & 7) * 2 + (xj >> 4), qblk = xj & 15, b = bh >> 3, h = bh & 7;
    const char* kbase = (const char*)(Kb + (size_t)(b * 16 + 2 * h) * KALL * 64);
    const char* vbase = (const char*)(Vtb + (size_t)(b * 8 + h) * 128 * KALL);
    const int qrow = qblk * 128 + qg * 32 + ql;
    const u16* qp = Qb + ((size_t)(b * 16 + 2 * h + sub) * SEQ + qrow) * 64 + 8 * hh;
    bf16x8 qf[4];
#pragma unroll
    for (int ks = 0; ks < 4; ++ks) qf[ks] = *(const bf16x8*)(qp + 16 * ks);
    float nshift;
    { const float* kp = (const float*)(p.ws + WS_KPART) + (b * 16 + 2 * h + sub) * 8;
      float k2 = 0.f;
#pragma unroll
      for (int e = 0; e < 8; ++e) k2 += kp[e];
      float q2 = 0.f;
#pragma unroll
      for (int ks = 0; ks < 4; ++ks)
#pragma unroll
        for (int e = 0; e < 8; ++e) { const float qv = bf1((u16)qf[ks][e]); q2 += qv * qv; }
      q2 += bperm(px, q2);
      nshift = -sqrtf(q2 * k2); }
    const bool zs = __builtin_amdgcn_ballot_w64(nshift < -100.f) == 0ull;
    u32x4 ra[4];
#define AT_LOAD(kt_) do { const char* kb_ = kbase + (size_t)(kt_) * 8192; const char* vb_ = vbase + (size_t)(kt_) * 128; \
      ra[0] = *(const u32x4*)(kb_ + koff); ra[1] = *(const u32x4*)(kb_ + (size_t)KALL * 128 + koff); ra[2] = *(const u32x4*)(vb_ + voff); ra[3] = *(const u32x4*)(vb_ + (size_t)64 * KALL * 2 + voff); } while (0)
#define AT_WRITE(sn_) do { LAS unsigned char* s_ = (sn_); \
      *(LAS u32x4*)(s_ + krow * AT_KSTR + kc * 16) = ra[0]; *(LAS u32x4*)(s_ + AT_K1 + krow * AT_KSTR + kc * 16) = ra[1]; \
      *(LAS u32x2*)(s_ + AT_V + krow * AT_VSTR + kc * 16) = (u32x2){ra[2].x, ra[2].y}; *(LAS u32x2*)(s_ + AT_V + krow * AT_VSTR + kc * 16 + 8) = (u32x2){ra[2].z, ra[2].w}; \
      *(LAS u32x2*)(s_ + AT_V + (64 + krow) * AT_VSTR + kc * 16) = (u32x2){ra[3].x, ra[3].y}; *(LAS u32x2*)(s_ + AT_V + (64 + krow) * AT_VSTR + kc * 16 + 8) = (u32x2){ra[3].z, ra[3].w}; } while (0)
    AT_LOAD(0);
    __syncthreads();
    AT_WRITE(lds);
    __syncthreads();
    f32x16 O[4];
#pragma unroll
    for (int blk = 0; blk < 4; ++blk)
#pragma unroll
      for (int r = 0; r < 16; ++r) O[blk][r] = 0.f;
    float l = 0.f;
    if (zs) {
      for (int kt = 0; kt < KALL / 64; ++kt) {
        const bool more = kt + 1 < KALL / 64;
        if (more) AT_LOAD(kt + 1);
        att_tile<true>(lds + (kt & 1) * AT_STAGE, sub, ql, hh, qf, 0.f, O, l);
        if (more) AT_WRITE(lds + ((kt + 1) & 1) * AT_STAGE);
        __syncthreads();
      }
    } else {
      for (int kt = 0; kt < KALL / 64; ++kt) {
        const bool more = kt + 1 < KALL / 64;
        if (more) AT_LOAD(kt + 1);
        att_tile<false>(lds + (kt & 1) * AT_STAGE, sub, ql, hh, qf, nshift, O, l);
        if (more) AT_WRITE(lds + ((kt + 1) & 1) * AT_STAGE);
        __syncthreads();
      }
    }
#undef AT_LOAD
#undef AT_WRITE
    l += bperm(px, l);
    const float invl = 1.f / l;
    LAS float* X = (LAS float*)lds + qg * 4096;
    if (sub == 1) {
#pragma unroll
      for (int blk = 0; blk < 4; ++blk)
#pragma unroll
        for (int r = 0; r < 16; ++r) { const int dv = 32 * blk + (r & 3) + 8 * (r >> 2) + 4 * hh; X[dv * 32 + ql] = O[blk][r] * invl; }
    }
    __syncthreads();
    if (sub == 0) {
      float ss = 0.f;
#pragma unroll
      for (int blk = 0; blk < 4; ++blk)
#pragma unroll
        for (int r = 0; r < 16; ++r) { const int dv = 32 * blk + (r & 3) + 8 * (r >> 2) + 4 * hh; const float o = O[blk][r] * invl - lam * X[dv * 32 + ql]; O[blk][r] = o; ss += o * o; }
      ss += bperm(px, ss);
      const float rinv = rsqrtf(ss * (1.f / 128.f) + 1e-5f) * 0.8f;
      u16* grow = G + (size_t)(b * SEQ + qrow) * 2048 + h * 128;
#pragma unroll
      for (int blk = 0; blk < 4; ++blk)
#pragma unroll
        for (int g4 = 0; g4 < 4; ++g4) {
          const int dv = 32 * blk + 8 * g4 + 4 * hh;
          const f32x4 sg = *(const f32x4*)(p.in[I_SUBLN] + dv);
          const u32x2 gg = *(const u32x2*)(grow + dv);
          u32x2 o;
          o.x = pk2(O[blk][4 * g4] * rinv * sg[0] * bflo(gg.x), O[blk][4 * g4 + 1] * rinv * sg[1] * bfhi(gg.x));
          o.y = pk2(O[blk][4 * g4 + 2] * rinv * sg[2] * bflo(gg.y), O[blk][4 * g4 + 3] * rinv * sg[3] * bfhi(gg.y));
          if (dry) *(u32x2*)((u16*)(p.ws + WS_HC) + (size_t)(b * SEQ + qrow) * 128 + dv) = o; else *(u32x2*)(grow + dv) = o;
        }
    }
  }
  __syncthreads();
}

constexpr int CV_USTR = 4112;
constexpr int CV_FL = 66048;
constexpr int CV_FW = 2064;
DI void toeplitz_mma(f32x4 (&acc)[16], const LAS unsigned* FLo, const LAS unsigned char* U, int wv, int lane) {
  const int i = lane & 15, kq = lane >> 4;
  const int base = 2047 - 256 * wv - i + 8 * kq;
  const LAS unsigned* fl = FLo + (base & 1) * CV_FW + (base >> 1);
  const LAS unsigned char* ub = U + i * CV_USTR + kq * 16;
  bf16x8 win[16];
#pragma unroll
  for (int a = 0; a < 16; ++a) { const LAS unsigned* q = fl - 8 * a; u32x4 w = {q[0], q[1], q[2], q[3]}; win[a] = __builtin_bit_cast(bf16x8, w); }
  for (int so = 0; so < 8; ++so) {
#pragma unroll
    for (int si = 0; si < 8; ++si) {
      const int sg = so * 8 + si;
      const bf16x8 bfr = *(const LAS bf16x8*)(ub + 64 * sg);
      const LAS unsigned* q0 = fl + 16 * sg + 16; const LAS unsigned* q1 = fl + 16 * sg + 8;
      const u32x4 w0 = {q0[0], q0[1], q0[2], q0[3]}, w1 = {q1[0], q1[1], q1[2], q1[3]};
#pragma unroll
      for (int a = 0; a < 16; ++a) acc[a] = __builtin_amdgcn_mfma_f32_16x16x32_bf16(win[(a - 2 * si + 16) & 15], bfr, acc[a], 0, 0, 0);
      win[(-2 * si - 2 + 32) & 15] = __builtin_bit_cast(bf16x8, w0);
      win[(-2 * si - 1 + 32) & 15] = __builtin_bit_cast(bf16x8, w1);
    }
  }
}
DI f32x4 sconv4(const u16* row, int t, float w0, float w1, float w2, float cb) {
  const u32x2 c = *(const u32x2*)(row + t);
  const float xm = t > 0 ? bf1(row[t - 1]) : 0.f, xp = t + 4 < SEQ ? bf1(row[t + 4]) : 0.f;
  const float x0 = bflo(c.x), x1 = bfhi(c.x), x2 = bflo(c.y), x3 = bfhi(c.y);
  f32x4 r; r[0] = cb + w0 * xm + w1 * x0 + w2 * x1; r[1] = cb + w0 * x0 + w1 * x1 + w2 * x2; r[2] = cb + w0 * x1 + w1 * x2 + w2 * x3; r[3] = cb + w0 * x2 + w1 * x3 + w2 * xp;
  return r;
}
constexpr int CV_X = 65792;
constexpr int CV_FL1 = 131584;
DI void conv_load_row(const u16* row, const u16* grow, LAS unsigned char* dst, float w0, float w1, float w2, float cb, int tid) {
  u32x4 cur[8], gt[8]; unsigned hm[8], hp[8];
  const bool first = (tid & 255) == 0, last = (tid & 255) == 255;
  const u16* r = row + (size_t)tid * 8;
#pragma unroll
  for (int kj = 0; kj < 8; ++kj) {
    const u16* rk = r + (size_t)kj * 4096;
    cur[kj] = *(const u32x4*)rk;
    hm[kj] = first ? 0u : (unsigned)rk[-1];
    hp[kj] = last ? 0u : (unsigned)rk[8];
  }
  if (grow) {
    const u16* g = grow + (size_t)tid * 8;
#pragma unroll
    for (int kj = 0; kj < 8; ++kj) gt[kj] = *(const u32x4*)(g + (size_t)kj * 4096);
  }
#pragma unroll
  for (int kj = 0; kj < 8; ++kj) {
    const int k = tid + 512 * kj, b = k >> 8, t0 = (k & 255) * 8;
    const u32x4 c4 = cur[kj];
    float x[10]; x[0] = __uint_as_float(hm[kj] << 16); x[1] = bflo(c4.x); x[2] = bfhi(c4.x); x[3] = bflo(c4.y); x[4] = bfhi(c4.y); x[5] = bflo(c4.z); x[6] = bfhi(c4.z); x[7] = bflo(c4.w); x[8] = bfhi(c4.w); x[9] = __uint_as_float(hp[kj] << 16);
    float y[8];
#pragma unroll
    for (int e = 0; e < 8; ++e) y[e] = cb + w0 * x[e] + w1 * x[e + 1] + w2 * x[e + 2];
    if (grow) { const u32x4 g = gt[kj];
      y[0] *= silu_f(bflo(g.x)); y[1] *= silu_f(bfhi(g.x)); y[2] *= silu_f(bflo(g.y)); y[3] *= silu_f(bfhi(g.y)); y[4] *= silu_f(bflo(g.z)); y[5] *= silu_f(bfhi(g.z)); y[6] *= silu_f(bflo(g.w)); y[7] *= silu_f(bfhi(g.w)); }
    u32x4 o; o.x = pk2(y[0], y[1]); o.y = pk2(y[2], y[3]); o.z = pk2(y[4], y[5]); o.w = pk2(y[6], y[7]);
    *(LAS u32x4*)(dst + b * CV_USTR + t0 * 2) = o;
  }
}
DI void conv_load_filter(const u16* Fco, LAS unsigned* FLw, int tid) {
  const unsigned* Fg = (const unsigned*)Fco;
#pragma unroll
  for (int kj = 0; kj < 4; ++kj) { const int k = tid + 512 * kj; const unsigned w0 = Fg[k], w1 = (k + 1 < 2048) ? Fg[k + 1] : 0u;
    FLw[k] = w0; FLw[CV_FW + k] = (w0 >> 16) | (w1 << 16); }
  if (tid < 16) { FLw[2048 + tid] = 0u; FLw[CV_FW + 2048 + tid] = 0u; }
}
DI void conv_phase(const Params& p, LAS unsigned char* lds, int grp, int wv) {
  const int lane = lane_id(), tid = wv * 64 + lane;
  const u16* Ut = (const u16*)(p.ws + WS_UT);
  const u16* F = (const u16*)(p.ws + WS_F);
  u16* Zt = (u16*)(p.ws + WS_ZT);
  LAS unsigned* FLw = (LAS unsigned*)(lds + CV_FL1);
  const float* cw = p.in[I_CONVW]; const float* cbp = p.in[I_CONVB]; const float* fb = p.in[I_FBIAS];
  for (int ci = 0; ci < 2; ++ci) {
    const int cc = blockIdx.x * 2 + ci, c = grp * 512 + cc;
    __syncthreads();
    conv_load_filter(F + (size_t)(c * 2) * 4096, FLw, tid);
    conv_load_row(Ut + (size_t)cc * NTOK, nullptr, lds, cw[c], cw[6144 + c], cw[2 * 6144 + c], cbp[c], tid);
    conv_load_row(Ut + (size_t)(512 + cc) * NTOK, nullptr, lds + CV_X, cw[2048 + c], cw[6144 + 2048 + c], cw[2 * 6144 + 2048 + c], cbp[2048 + c], tid);
    __syncthreads();
    f32x4 acc[16];
#pragma unroll
    for (int a = 0; a < 16; ++a) acc[a] = (f32x4){0.f, 0.f, 0.f, 0.f};
    toeplitz_mma(acc, FLw, lds, wv, lane);
    {
      const int l2 = lane_id(), b = l2 & 15, kq = l2 >> 4;
      const float bias = fb[c];
#pragma unroll
      for (int a = 0; a < 16; ++a) {
        const int t = 256 * wv + 16 * a + 4 * kq;
        const u32x2 uu = *(const LAS u32x2*)(lds + b * CV_USTR + t * 2), xx = *(const LAS u32x2*)(lds + CV_X + b * CV_USTR + t * 2);
        const f32x4 u4 = {bflo(uu.x), bfhi(uu.x), bflo(uu.y), bfhi(uu.y)}, x4 = {bflo(xx.x), bfhi(xx.x), bflo(xx.y), bfhi(xx.y)};
        acc[a] = x4 * (acc[a] + bias * u4);
      }
    }
    __syncthreads();
    { const int l2 = lane_id(), b = l2 & 15, kq = l2 >> 4;
#pragma unroll
      for (int a = 0; a < 16; ++a) {
        const int t = 256 * wv + 16 * a + 4 * kq;
        u32x2 o; o.x = pk2(acc[a][0], acc[a][1]); o.y = pk2(acc[a][2], acc[a][3]);
        *(LAS u32x2*)(lds + b * CV_USTR + t * 2) = o;
        acc[a] = (f32x4){0.f, 0.f, 0.f, 0.f};
      } }
    { const int t2 = wv * 64 + lane_id();
      conv_load_filter(F + (size_t)(c * 2 + 1) * 4096, FLw, t2);
      conv_load_row(Ut + (size_t)(1024 + cc) * NTOK, Ut + (size_t)(1536 + cc) * NTOK, lds + CV_X, cw[4096 + c], cw[6144 + 4096 + c], cw[2 * 6144 + 4096 + c], cbp[4096 + c], t2); }
    __syncthreads();
    toeplitz_mma(acc, FLw, lds, wv, lane);
    {
      const int l2 = lane_id(), b = l2 & 15, kq = l2 >> 4;
      const float bias = fb[2048 + c];
#pragma unroll
      for (int a = 0; a < 16; ++a) {
        const int t = 256 * wv + 16 * a + 4 * kq;
        const u32x2 uu = *(const LAS u32x2*)(lds + b * CV_USTR + t * 2), xx = *(const LAS u32x2*)(lds + CV_X + b * CV_USTR + t * 2);
        const f32x4 z4 = {bflo(uu.x), bfhi(uu.x), bflo(uu.y), bfhi(uu.y)}, x4 = {bflo(xx.x), bfhi(xx.x), bflo(xx.y), bfhi(xx.y)};
        const f32x4 r = x4 * (acc[a] + bias * z4);
        u32x2 o; o.x = pk2(r[0], r[1]); o.y = pk2(r[2], r[3]);
        *(LAS u32x2*)(lds + CV_X + b * CV_USTR + t * 2) = o;
      }
    }
    __syncthreads();
    { const int t2 = wv * 64 + lane_id();
      u16* zrow = Zt + (size_t)c * NTOK;
#pragma unroll
      for (int kj = 0; kj < 8; ++kj) { const int k = t2 + 512 * kj, b = k >> 8, t0 = (k & 255) * 8;
        *(u32x4*)(zrow + (size_t)k * 8) = *(const LAS u32x4*)(lds + CV_X + b * CV_USTR + t0 * 2); } }
  }
  __syncthreads();
}

DI void transpose_phase(const Params& p, LAS unsigned char* lds, int wv) {
  const int lane = lane_id(), wave = wv;
  const u16* Zt = (const u16*)(p.ws + WS_ZT); u16* Z = (u16*)(p.ws + WS_Z);
  LAS unsigned char* scr = lds + wave * (64 * 144);
  for (int it = blockIdx.x * 8 + wave; it < 32 * 512; it += gridDim.x * 8) {
    const int cb = it & 31, tb = it >> 5, c0 = cb * 64, tok0 = tb * 64;
#pragma unroll
    for (int i = 0; i < 8; ++i) { const int cr = (lane >> 3) + 8 * i, tc = lane & 7;
      *(LAS u32x4*)(scr + cr * 144 + tc * 16) = *(const u32x4*)(Zt + (size_t)(c0 + cr) * NTOK + tok0 + tc * 8); }
    __builtin_amdgcn_wave_barrier();
#pragma unroll
    for (int i = 0; i < 8; ++i) { const int tk = (lane >> 3) + 8 * i, cc = lane & 7;
      const LAS u16* s = (const LAS u16*)(scr + (cc * 8) * 144 + tk * 2);
      u32x4 o;
      o.x = (unsigned)s[0] | ((unsigned)s[72] << 16); o.y = (unsigned)s[144] | ((unsigned)s[216] << 16);
      o.z = (unsigned)s[288] | ((unsigned)s[360] << 16); o.w = (unsigned)s[432] | ((unsigned)s[504] << 16);
      *(u32x4*)(Z + (size_t)(tok0 + tk) * 2048 + c0 + cc * 8) = o; }
    __builtin_amdgcn_wave_barrier();
  }
}

#define GS() do { ep += gridDim.x; gsync(bar, ep, wv); } while (0)
__global__ void __launch_bounds__(512, 2) fwd_megakernel(Params p) {
  extern __shared__ __attribute__((aligned(16))) unsigned char shm[];
  LAS unsigned char* lds = (LAS unsigned char*)shm;
  const int wv = __builtin_amdgcn_readfirstlane((int)threadIdx.x >> 6);
  cg::this_grid().sync();
  unsigned char* ws = p.ws;
  unsigned* bar = (unsigned*)ws; unsigned ep = 0;
  const int bid = blockIdx.x;
  u16* Qb = (u16*)p.out; u16* Pb = (u16*)((unsigned char*)p.out + 64 * MB);
  float* gate = (float*)(ws + WS_GATE);

  phase0(p, lds, wv);
  GS();
  phase1(p, lds, wv);
  GS();
  { EpiL0Main E; E.Q = Qb; E.K = (u16*)(ws + WS_K); E.P = Pb; E.G = (u16*)(ws + WS_G); E.rope = (const float*)(ws + WS_ROPE); E.kpart = (unsigned*)(ws + WS_KPART);
    run_gemm(wv, lds, (const u16*)(ws + WS_H), 1024, (const u16*)(ws + WS_WA), 1024, NTOK, 5120, 1024, 0, E);
#ifdef REP_G0
    run_gemm(wv, lds, (const u16*)(ws + WS_H), 1024, (const u16*)(ws + WS_WA), 1024, NTOK, 5120, 1024, 0, E);
#endif
  }
  { EpiVt E; E.Vt = (u16*)(ws + WS_VT); E.shift = 11; E.toff = CTXL;
    run_gemm(wv, lds, (const u16*)(ws + WS_WA) + (size_t)5120 * 1024, 1024, (const u16*)(ws + WS_H), 1024, 1024, NTOK, 1024, 0, E); }
  { EpiCtxK E; E.K = (u16*)(ws + WS_K); E.kpart = (unsigned*)(ws + WS_KPART);
    run_gemm(wv, lds, (const u16*)(ws + WS_HC), 1024, (const u16*)(ws + WS_WA) + (size_t)1024 * 1024, 1024, NCTX, 1024, 1024, 0, E); }
  { EpiVt E; E.Vt = (u16*)(ws + WS_VT); E.shift = 8; E.toff = 0;
    run_gemm(wv, lds, (const u16*)(ws + WS_WA) + (size_t)5120 * 1024, 1024, (const u16*)(ws + WS_HC), 1024, 1024, NCTX, 1024, 192, E); }
  GS();
  pool_means(p, wv);
#ifdef REP_ATT
  attention_phase(p, lds, wv, true);
#endif
  attention_phase(p, lds, wv);
  GS();
  { EpiResid E; E.src = p.in[I_X]; E.dst = p.out; E.gate = gate;
    run_gemm(wv, lds, (const u16*)(ws + WS_G), 2048, (const u16*)(ws + WS_WAO), 2048, NTOK, 1024, 2048, 0, E); }
  GS();
  {
    const int lane = lane_id(), wave = wv;
    LAS float* gs = (LAS float*)lds; LAS float* sh = gs + 1024;
    const int b = bid >> 4;
    mod_vectors(p, wv, 1, b, gs, sh, (bid & 15) == 0 ? gate + 16384 + b * 1024 : nullptr);
    __syncthreads();
    for (int i = 0; i < 16; ++i) { const int row = bid * 128 + wave * 16 + i; mod_row(p.out + (size_t)row * 1024, (u16*)(ws + WS_H) + (size_t)row * 1024, gs, sh, lane); }
    __syncthreads();
  }
  GS();
  for (int grp = 0; grp < 4; ++grp) {
    { EpiPlain E; E.O = (u16*)(ws + WS_UT); E.ldc = NTOK;
      run_gemm(wv, lds, (const u16*)(ws + WS_WH) + (size_t)grp * 2048 * 1024, 1024, (const u16*)(ws + WS_H), 1024, 2048, NTOK, 1024, 0, E);
#ifdef REP_G1
      run_gemm(wv, lds, (const u16*)(ws + WS_WH) + (size_t)grp * 2048 * 1024, 1024, (const u16*)(ws + WS_H), 1024, 2048, NTOK, 1024, 0, E);
#endif
    }
    GS();
    conv_phase(p, lds, grp, wv);
#ifdef REP_CONV
    conv_phase(p, lds, grp, wv);
#endif
    GS();
  }
  transpose_phase(p, lds, wv);
  GS();
  { EpiResid E; E.src = p.out; E.dst = p.out; E.gate = gate + 16384;
    run_gemm(wv, lds, (const u16*)(ws + WS_Z), 2048, (const u16*)(ws + WS_WHO), 2048, NTOK, 1024, 2048, 0, E); }
  GS();
  const int lane = lane_id(), wave = wv;
  for (int i = 0; i < 16; ++i) {
    const int row = bid * 128 + wave * 16 + i; float* xr = p.out + (size_t)row * 1024;
    f32x4 v[4]; float ss = 0.f;
#pragma unroll
    for (int j = 0; j < 4; ++j) { v[j] = *(const f32x4*)(xr + 4 * lane + 256 * j); ss += (v[j][0] * v[j][0] + v[j][1] * v[j][1]) + (v[j][2] * v[j][2] + v[j][3] * v[j][3]); }
    const float rstd = rsqrtf(wave_sum(ss) * (1.f / 1024.f) + 1e-6f);
#pragma unroll
    for (int j = 0; j < 4; ++j) { const f32x4 g4 = *(const f32x4*)(p.in[I_FINALG] + 4 * lane + 256 * j); *(f32x4*)(xr + 4 * lane + 256 * j) = v[j] * rstd * g4; }
  }
}

constexpr int LDS_BYTES = 148480;

extern "C" void kernel_launch(void* const* d_in, const int* in_sizes, int n_in, void* d_out, int out_size, void* d_ws, size_t ws_size, hipStream_t stream) {
  static int grid_blocks = 0;
  if (grid_blocks == 0) {
    if (n_in != 32 || out_size != NTOK * DM || ws_size < WS_END) { fprintf(stderr, "kernel_launch: unexpected shapes (n_in %d out %d ws %zu)\n", n_in, out_size, ws_size); grid_blocks = -1; return; }
    int dev = 0, cus = 0, per_cu = 0;
    hipGetDevice(&dev);
    hipDeviceGetAttribute(&cus, hipDeviceAttributeMultiprocessorCount, dev);
    if (hipFuncSetAttribute((const void*)fwd_megakernel, hipFuncAttributeMaxDynamicSharedMemorySize, LDS_BYTES) != hipSuccess) { fprintf(stderr, "hipFuncSetAttribute failed\n"); grid_blocks = -1; return; }
    hipOccupancyMaxActiveBlocksPerMultiprocessor(&per_cu, (const void*)fwd_megakernel, 512, LDS_BYTES);
    if (per_cu < 1 || cus < 256) { fprintf(stderr, "occupancy %d cus %d\n", per_cu, cus); grid_blocks = -1; return; }
    grid_blocks = 256;
  }
  if (grid_blocks < 0) return;
  if (hipMemsetAsync(d_ws, 0, WS_KPART + 8192, stream) != hipSuccess) { fprintf(stderr, "memset failed\n"); return; }
  Params p{};
  for (int i = 0; i < 32; ++i) p.in[i] = (const float*)d_in[i];
  p.out = (float*)d_out; p.ws = (unsigned char*)d_ws;
  void* args[] = {&p};
  hipError_t e = hipLaunchCooperativeKernel((void*)fwd_megakernel, dim3(grid_blocks), dim3(512), args, LDS_BYTES, stream);
  if (e != hipSuccess) fprintf(stderr, "cooperative launch failed: %s\n", hipGetErrorString(e));
}
```

```cpp
#include <hip/hip_runtime.h>
#include <hip/hip_cooperative_groups.h>
#include <cstdio>
#include <cstdint>
namespace cg = cooperative_groups;

#define DI __device__ __forceinline__
#define LAS __attribute__((address_space(3)))
typedef unsigned short u16;
typedef short bf16x8 __attribute__((ext_vector_type(8)));
typedef float f32x4 __attribute__((ext_vector_type(4)));
typedef float f32x2 __attribute__((ext_vector_type(2)));
typedef float f32x16 __attribute__((ext_vector_type(16)));
typedef unsigned u32x4 __attribute__((ext_vector_type(4)));
typedef unsigned u32x2 __attribute__((ext_vector_type(2)));
typedef __bf16 bf16x2_t __attribute__((ext_vector_type(2)));

DI unsigned pk2(float lo, float hi) { bf16x2_t v = __builtin_convertvector((f32x2){lo, hi}, bf16x2_t); return __builtin_bit_cast(unsigned, v); }
DI float bflo(unsigned w) { return __uint_as_float(w << 16); }
DI float bfhi(unsigned w) { return __uint_as_float(w & 0xffff0000u); }
DI float bf1(u16 h) { return __uint_as_float(((unsigned)h) << 16); }
DI float silu_f(float v) { return v * __builtin_amdgcn_rcpf(1.f + __builtin_amdgcn_exp2f(-1.4426950408889634f * v)); }
template <int M> DI float swz_xor(float v) { return __int_as_float(__builtin_amdgcn_ds_swizzle(__float_as_int(v), 0x1f | (M << 10))); }
DI float wave_sum(float v) {
  v += swz_xor<1>(v); v += swz_xor<2>(v); v += swz_xor<4>(v); v += swz_xor<8>(v); v += swz_xor<16>(v);
  return __uint_as_float(__builtin_amdgcn_readlane(__float_as_uint(v), 0)) + __uint_as_float(__builtin_amdgcn_readlane(__float_as_uint(v), 32));
}
DI float bperm(int idx4, float v) { return __int_as_float(__builtin_amdgcn_ds_bpermute(idx4, __float_as_int(v))); }

DI int lane_id() { int l; asm volatile("v_mbcnt_lo_u32_b32 %0, -1, 0\n\tv_mbcnt_hi_u32_b32 %0, -1, %0" : "=v"(l)); return l; }
#define OTID(wv) ((wv) * 64 + lane_id())
DI void gsync(unsigned* bar, unsigned target, int wv) {
  __syncthreads();
  if (wv == 0 && lane_id() == 0) {
    __hip_atomic_fetch_add(bar, 1u, __ATOMIC_RELEASE, __HIP_MEMORY_SCOPE_AGENT);
    while (__hip_atomic_load(bar, __ATOMIC_RELAXED, __HIP_MEMORY_SCOPE_AGENT) < target) __builtin_amdgcn_s_sleep(2);
    __builtin_amdgcn_fence(__ATOMIC_ACQUIRE, "agent");
  }
  __syncthreads();
}
constexpr int NB = 16, SEQ = 2048, DM = 1024, NTOK = NB * SEQ, CTXL = 256, NCTX = NB * CTXL, KALL = SEQ + CTXL;
constexpr size_t MB = 1024 * 1024;
constexpr size_t WS_ROPE = 4096;
constexpr size_t WS_GATE = 16384;
constexpr size_t WS_KPART = 147456;
constexpr size_t WS_GS1 = 155648;
constexpr size_t WS_SH1B = 4 * MB + 512 * 1024;
constexpr size_t WS_CVEC = 21 * MB + 512 * 1024;
constexpr size_t WS_ADAP = 256 * 1024;
constexpr size_t WS_H3 = 4 * MB;
constexpr size_t WS_WA = 5 * MB;
constexpr size_t WS_WAO = 17 * MB;
constexpr size_t WS_PW = 21 * MB;
constexpr size_t WS_WH = 22 * MB;
constexpr size_t WS_WHO = 38 * MB;
constexpr size_t WS_F = 42 * MB;
constexpr size_t WS_H = 74 * MB;
constexpr size_t WS_L = 138 * MB;
constexpr size_t WS_HC = WS_L;
constexpr size_t WS_K = WS_L + 8 * MB;
constexpr size_t WS_VT = WS_K + 72 * MB;
constexpr size_t WS_G = WS_VT + 72 * MB;
constexpr size_t WS_UT = WS_L;
constexpr size_t WS_ZT = WS_L + 128 * MB;
constexpr size_t WS_Z = WS_H;
constexpr size_t WS_ROWSS = 420 * MB;
constexpr size_t WS_END = 421 * MB;

struct Params { const float* in[32]; float* out; unsigned char* ws; };
enum { I_X = 0, I_C, I_CTX, I_CCTX, I_NORMG, I_ADAW, I_ADAB, I_FINALG, I_AWIN, I_LQ1, I_LK1, I_LQ2, I_LK2, I_SUBLN, I_POOLW, I_POOLS, I_AWOUT,
       I_HWIN, I_CONVW, I_CONVB, I_FW0, I_FB0, I_FF0, I_FW1, I_FB1, I_FF1, I_FW2, I_FB2, I_FF2, I_FWOUT, I_FBIAS, I_HWOUT };

namespace pg8 {
constexpr int BM = 256, BK = 64, HALF = 128, HTB = HALF * BK * 2, STAGE_BYTES = 8 * HTB, NXCD = 8, WGM = 8;
DI int lds_byte(int r, int c) { const int st = (r >> 4) * 2 + (c >> 5), rr = r & 15, cc = c & 31, ob = rr * 64 + cc * 2; return st * 1024 + (ob ^ (((ob >> 9) & 1) << 5)); }
DI void stage_rc(int b, int& R, int& C) { const int st = b / 1024, sb = b % 1024, swz = sb ^ (((sb >> 9) & 1) << 5); R = (st >> 1) * 16 + swz / 64; C = (st & 1) * 32 + (swz % 64) / 2; }
DI int perm32(int rho) { const int n = rho >> 4, i = rho & 15; return 8 * (i >> 2) + 4 * n + (i & 3); }
struct Unit { int pm, pn; };
struct Gemm { const u16* A; const u16* Bt; int M, N, K, lda, ldb; };
struct StaticOrder {
  int nM, nN, nwg, G, c;
  DI void init(int M, int N, int G_, int c_) { nM = M / BM; nN = N / BM; nwg = nM * nN; G = G_; c = c_; }
  DI bool next(int i, Unit& u) const {
    const long L = (long)i * G + c; if (L >= nwg) return false;
    int wgid = (int)L; { const int q = nwg / NXCD, r = nwg % NXCD, xcd = wgid % NXCD, off = wgid / NXCD; wgid = (xcd < r ? xcd * (q + 1) : r * (q + 1) + (xcd - r) * q) + off; }
    const int nig = WGM * nN, gid = wgid / nig, fm = gid * WGM, gsz = (nM - fm) < WGM ? (nM - fm) : WGM;
    u.pm = fm + ((wgid % nig) % gsz); u.pn = (wgid % nig) / gsz; return true;
  }
};
template <class Epi>
DI void gemm_phase(LAS unsigned char* lds, const Gemm g, const StaticOrder& S, const Epi& E, int wv) {
  const int wid = wv, lane = lane_id(), tid = wid * 64 + lane, wr = wid >> 2, wc = wid & 3, fr = lane & 15, fq = lane >> 4;
  const int K = g.K, nt = K / BK;
  unsigned voffA[2], voffB[2];
#pragma unroll
  for (int i = 0; i < 2; ++i) { int R, C; stage_rc(tid * 16 + i * 8192, R, C); const int Rb = Epi::PERM ? ((R & ~31) + perm32(R & 31)) : R;
    voffA[i] = (unsigned)(R * g.lda + C) * 2u; voffB[i] = (unsigned)(Rb * g.ldb + C) * 2u; }
  const size_t kstep = (size_t)(BK * 2);
  const size_t hstepA = (size_t)HALF * g.lda * 2, hstepB = (size_t)HALF * g.ldb * 2;
  const size_t tstepA = 2 * hstepA, tstepB = 2 * hstepB;
  const unsigned ldsw = (unsigned)wid * 1024u;
  const int aoff = lds_byte(wr * 64 + fr, fq * 8), boff = lds_byte(wc * 32 + fr, fq * 8);
#define PG8_SA(b, h) (((b) * 2 + (h)) * HTB)
#define PG8_SB(b, h) ((4 + (b) * 2 + (h)) * HTB)
#define PG8_STAGE(bufoff, gbase, voff) do { _Pragma("unroll") for (int _i = 0; _i < 2; ++_i) \
    __builtin_amdgcn_global_load_lds((const unsigned*)((const char*)(gbase) + (voff)[_i]), (LAS unsigned*)(lds + (bufoff) + ldsw + _i * 8192), 16, 0, 0); } while (0)
#define PG8_LDA(dst, b, h) do { _Pragma("unroll") for (int m = 0; m < 4; ++m) _Pragma("unroll") for (int k = 0; k < 2; ++k) dst[m][k] = *(const LAS bf16x8*)(lds + PG8_SA(b, h) + aoff + m * 2048 + k * 1024); } while (0)
#define PG8_LDB(dst, b, h) do { _Pragma("unroll") for (int n = 0; n < 2; ++n) _Pragma("unroll") for (int k = 0; k < 2; ++k) dst[n][k] = *(const LAS bf16x8*)(lds + PG8_SB(b, h) + boff + n * 2048 + k * 1024); } while (0)
#define PG8_MMA(ai, bj, At, Bt) do { __builtin_amdgcn_s_setprio(1); _Pragma("unroll") for (int m = 0; m < 4; ++m) _Pragma("unroll") for (int n = 0; n < 2; ++n) _Pragma("unroll") for (int k = 0; k < 2; ++k) \
    acc[ai][bj][m][n] = __builtin_amdgcn_mfma_f32_16x16x32_bf16(Bt[n][k], At[m][k], acc[ai][bj][m][n], 0, 0, 0); __builtin_amdgcn_s_setprio(0); } while (0)
#define PG8_WAIT_V(n) asm volatile("s_waitcnt vmcnt(" #n ")" ::: "memory")
#define PG8_WAIT_L(n) asm volatile("s_waitcnt lgkmcnt(" #n ")" ::: "memory")
#define PG8_BAR __builtin_amdgcn_s_barrier()
#define PG8_SCHED __builtin_amdgcn_sched_barrier(0)
  Unit cur, nxt; int ui = 0;
  if (!S.next(0, cur)) return;
  f32x4 acc[2][2][4][2];
#pragma unroll
  for (int a = 0; a < 2; ++a)
#pragma unroll
    for (int b = 0; b < 2; ++b)
#pragma unroll
      for (int m = 0; m < 4; ++m)
#pragma unroll
        for (int n = 0; n < 2; ++n) acc[a][b][m][n] = (f32x4){0.f, 0.f, 0.f, 0.f};
  bf16x8 At[4][2], B0[2][2], B1[2][2];
  const char* cA = (const char*)g.A + (size_t)cur.pm * tstepA; const char* cB = (const char*)g.Bt + (size_t)cur.pn * tstepB;
  PG8_STAGE(PG8_SB(0, 0), cB, voffB); PG8_STAGE(PG8_SA(0, 0), cA, voffA); PG8_STAGE(PG8_SB(0, 1), cB + hstepB, voffB); PG8_STAGE(PG8_SA(0, 1), cA + hstepA, voffA);
  if (wr == 1) PG8_BAR;
  PG8_WAIT_V(4); PG8_BAR;
  PG8_STAGE(PG8_SB(1, 0), cB + kstep, voffB); PG8_STAGE(PG8_SA(1, 0), cA + kstep, voffA); PG8_STAGE(PG8_SB(1, 1), cB + hstepB + kstep, voffB);
  PG8_WAIT_V(6); PG8_BAR;
  for (;;) {
    const bool has_next = S.next(ui + 1, nxt);
    const char* nA = has_next ? (const char*)g.A + (size_t)nxt.pm * tstepA : cA; const char* nB = has_next ? (const char*)g.Bt + (size_t)nxt.pn * tstepB : cB;
    for (int t = 0; t < nt; t += 2) {
      const bool last = (t == nt - 2);
      const char* a1 = cA + (size_t)(t + 1) * kstep;
      const char* a2 = last ? nA : cA + (size_t)(t + 2) * kstep; const char* b2 = last ? nB : cB + (size_t)(t + 2) * kstep;
      const char* a3 = a2 + kstep; const char* b3 = b2 + kstep;
      PG8_LDB(B0, 0, 0); PG8_SCHED; PG8_LDA(At, 0, 0); PG8_STAGE(PG8_SA(1, 1), a1 + hstepA, voffA);
      PG8_WAIT_L(8); PG8_BAR; PG8_WAIT_L(0); PG8_MMA(0, 0, At, B0); PG8_BAR; PG8_SCHED;
      PG8_LDB(B1, 0, 1); PG8_STAGE(PG8_SB(0, 0), b2, voffB);
      PG8_BAR; PG8_WAIT_L(0); PG8_MMA(0, 1, At, B1); PG8_BAR;
      PG8_LDA(At, 0, 1); PG8_STAGE(PG8_SA(0, 0), a2, voffA);
      PG8_BAR; PG8_WAIT_L(0); PG8_MMA(1, 0, At, B0); PG8_BAR; PG8_SCHED;
      PG8_STAGE(PG8_SB(0, 1), b2 + hstepB, voffB);
      PG8_WAIT_V(6); PG8_BAR; PG8_MMA(1, 1, At, B1); PG8_BAR;
      PG8_LDB(B0, 1, 0); PG8_SCHED; PG8_LDA(At, 1, 0); PG8_STAGE(PG8_SA(0, 1), a2 + hstepA, voffA);
      PG8_WAIT_L(8); PG8_BAR; PG8_WAIT_L(0); PG8_MMA(0, 0, At, B0); PG8_BAR; PG8_SCHED;
      PG8_LDB(B1, 1, 1); PG8_STAGE(PG8_SB(1, 0), b3, voffB);
      PG8_BAR; PG8_WAIT_L(0); PG8_MMA(0, 1, At, B1); PG8_BAR;
      PG8_LDA(At, 1, 1); PG8_STAGE(PG8_SA(1, 0), a3, voffA);
      PG8_BAR; PG8_WAIT_L(0); PG8_MMA(1, 0, At, B0); PG8_BAR; PG8_SCHED;
      PG8_STAGE(PG8_SB(1, 1), b3 + hstepB, voffB);
      PG8_WAIT_V(6); PG8_BAR; PG8_MMA(1, 1, At, B1); PG8_BAR;
    }
    E(acc, cur, wr, wc, fr, fq);
    if (!has_next) break;
#pragma unroll
    for (int a = 0; a < 2; ++a)
#pragma unroll
      for (int b = 0; b < 2; ++b)
#pragma unroll
        for (int m = 0; m < 4; ++m)
#pragma unroll
          for (int n = 0; n < 2; ++n) acc[a][b][m][n] = (f32x4){0.f, 0.f, 0.f, 0.f};
    cur = nxt; cA = nA; cB = nB; ++ui;
  }
  PG8_WAIT_V(0);
  if (wr == 0) PG8_BAR;
  PG8_BAR;
#undef PG8_SA
#undef PG8_SB
#undef PG8_STAGE
#undef PG8_LDA
#undef PG8_LDB
#undef PG8_MMA
#undef PG8_WAIT_V
#undef PG8_WAIT_L
#undef PG8_BAR
#undef PG8_SCHED
}
}
using pg8::Unit;
typedef f32x4 AccT[2][2][4][2];

DI u32x4 pack8(const f32x4& a, const f32x4& b) { u32x4 w; w.x = pk2(a[0], a[1]); w.y = pk2(a[2], a[3]); w.z = pk2(b[0], b[1]); w.w = pk2(b[2], b[3]); return w; }

struct EpiL0Main {
  static constexpr bool PERM = true;
  u16 *Q, *K, *P, *G; const float* rope; unsigned* kpart;
  DI void operator()(const AccT& acc, const Unit& u, int wr, int wc, int fr, int fq) const {
    const int pn = u.pn, row0 = u.pm * 256 + wr * 64 + fr;
    if (pn < 8) {
      const bool isq = pn < 4;
      const float sc = isq ? 0.125f * 1.4426950408889634f : 1.f;
      const int half = wc & 1, hi = fq >> 1, jj0 = 8 * (fq & 1), px = ((fq * 16 + fr) ^ 32) * 4;
      float nmax[2] = {0.f, 0.f};
#pragma unroll
      for (int ai = 0; ai < 2; ++ai)
#pragma unroll
        for (int m = 0; m < 4; ++m) {
          const int row = row0 + ai * 128 + m * 16, t = row & 2047, b = row >> 11;
          const int pos = half ? (t & 63) : (t >> 6);
          const f32x4 c0 = *(const f32x4*)(rope + pos * 16 + jj0), c1 = *(const f32x4*)(rope + pos * 16 + jj0 + 4);
          const f32x4 s0 = *(const f32x4*)(rope + 1024 + pos * 16 + jj0), s1 = *(const f32x4*)(rope + 1024 + pos * 16 + jj0 + 4);
#pragma unroll
          for (int bj = 0; bj < 2; ++bj) {
            f32x4 v0 = acc[ai][bj][m][0], v1 = acc[ai][bj][m][1], p0, p1;
#pragma unroll
            for (int e = 0; e < 4; ++e) { p0[e] = bperm(px, v0[e]); p1[e] = bperm(px, v1[e]); }
            f32x4 o0, o1;
            if (hi) { o0 = v0 * c0 + p0 * s0; o1 = v1 * c1 + p1 * s1; } else { o0 = v0 * c0 - p0 * s0; o1 = v1 * c1 - p1 * s1; }
            o0 *= sc; o1 *= sc;
            nmax[bj] = fmaxf(nmax[bj], (o0[0] * o0[0] + o0[1] * o0[1]) + (o0[2] * o0[2] + o0[3] * o0[3]) + (o1[0] * o1[0] + o1[1] * o1[1]) + (o1[2] * o1[2] + o1[3] * o1[3]));
            const int col = (pn & 3) * 256 + bj * 128 + wc * 32 + 8 * fq, sh = col >> 6, d = col & 63;
            u16* dst = isq ? Q + ((size_t)(b * 16 + sh) * SEQ + t) * 64 + d : K + ((size_t)(b * 16 + sh) * KALL + CTXL + t) * 64 + d;
            *(u32x4*)dst = pack8(o0, o1);
          }
        }
      if (!isq) {
        const int b = (u.pm * 256) >> 11;
#pragma unroll
        for (int bj = 0; bj < 2; ++bj) { const int sh = ((pn & 3) * 256 + bj * 128 + wc * 32) >> 6;
          atomicMax(kpart + (b * 16 + sh) * 8 + (wc & 1) * 4 + fq, __float_as_uint(nmax[bj] * 1.02f)); }
      }
    } else if (pn < 12) {
#pragma unroll
      for (int ai = 0; ai < 2; ++ai)
#pragma unroll
        for (int m = 0; m < 4; ++m) {
          const int row = row0 + ai * 128 + m * 16;
#pragma unroll
          for (int bj = 0; bj < 2; ++bj) {
            const int col = (pn - 8) * 256 + bj * 128 + wc * 32 + 8 * fq;
            *(u32x4*)(P + (size_t)row * 1024 + col) = pack8(acc[ai][bj][m][0], acc[ai][bj][m][1]);
          }
        }
    } else {
#pragma unroll
      for (int ai = 0; ai < 2; ++ai)
#pragma unroll
        for (int m = 0; m < 4; ++m) {
          const int row = row0 + ai * 128 + m * 16;
#pragma unroll
          for (int bj = 0; bj < 2; ++bj) {
            const int col = (pn - 12) * 256 + bj * 128 + wc * 32 + 8 * fq;
            f32x4 v0 = acc[ai][bj][m][0], v1 = acc[ai][bj][m][1];
#pragma unroll
            for (int e = 0; e < 4; ++e) { v0[e] = silu_f(v0[e]); v1[e] = silu_f(v1[e]); }
            *(u32x4*)(G + (size_t)row * 2048 + col) = pack8(v0, v1);
          }
        }
    }
  }
};
struct EpiVt {
  static constexpr bool PERM = true;
  u16* Vt; int shift, toff;
  DI void operator()(const AccT& acc, const Unit& u, int wr, int wc, int fr, int fq) const {
    const int f0 = u.pm * 256 + wr * 64 + fr;
#pragma unroll
    for (int ai = 0; ai < 2; ++ai)
#pragma unroll
      for (int m = 0; m < 4; ++m) {
        const int f = f0 + ai * 128 + m * 16;
#pragma unroll
        for (int bj = 0; bj < 2; ++bj) {
          const int tok = u.pn * 256 + bj * 128 + wc * 32 + 8 * fq, b = tok >> shift, t = tok & ((1 << shift) - 1);
          *(u32x4*)(Vt + ((size_t)(b * 8 + (f >> 7)) * 128 + (f & 127)) * KALL + toff + t) = pack8(acc[ai][bj][m][0], acc[ai][bj][m][1]);
        }
      }
  }
};
struct EpiCtxK {
  static constexpr bool PERM = true;
  u16* K; unsigned* kpart;
  DI void operator()(const AccT& acc, const Unit& u, int wr, int wc, int fr, int fq) const {
    const int row0 = u.pm * 256 + wr * 64 + fr;
    float nmax[2] = {0.f, 0.f};
#pragma unroll
    for (int ai = 0; ai < 2; ++ai)
#pragma unroll
      for (int m = 0; m < 4; ++m) {
        const int row = row0 + ai * 128 + m * 16, b = row >> 8, t = row & 255;
#pragma unroll
        for (int bj = 0; bj < 2; ++bj) {
          const int col = u.pn * 256 + bj * 128 + wc * 32 + 8 * fq, sh = col >> 6, d = col & 63;
          const f32x4 o0 = acc[ai][bj][m][0], o1 = acc[ai][bj][m][1];
          nmax[bj] = fmaxf(nmax[bj], (o0[0] * o0[0] + o0[1] * o0[1]) + (o0[2] * o0[2] + o0[3] * o0[3]) + (o1[0] * o1[0] + o1[1] * o1[1]) + (o1[2] * o1[2] + o1[3] * o1[3]));
          *(u32x4*)(K + ((size_t)(b * 16 + sh) * KALL + t) * 64 + d) = pack8(o0, o1);
        }
      }
    const int b = u.pm;
#pragma unroll
    for (int bj = 0; bj < 2; ++bj) { const int sh = (u.pn * 256 + bj * 128 + wc * 32) >> 6;
      atomicMax(kpart + (b * 16 + sh) * 8 + (wc & 1) * 4 + fq, __float_as_uint(nmax[bj] * 1.02f)); }
  }
};
struct EpiPool {
  static constexpr bool PERM = true;
  u16* G; const float* pscale; int grp;
  DI void operator()(const AccT& acc, const Unit& u, int wr, int wc, int fr, int fq) const {
    const int row0 = u.pm * 256 + wr * 64 + fr;
#pragma unroll
    for (int bj = 0; bj < 2; ++bj) {
      const int col = grp * 256 + bj * 128 + wc * 32 + 8 * fq;
      const f32x4 ps0 = *(const f32x4*)(pscale + col), ps1 = *(const f32x4*)(pscale + col + 4);
#pragma unroll
      for (int ai = 0; ai < 2; ++ai)
#pragma unroll
        for (int m = 0; m < 4; ++m) {
          const int row = row0 + ai * 128 + m * 16;
          u16* p = G + (size_t)row * 2048 + 1024 + col;
          const u32x4 gv = *(const u32x4*)p;
          f32x4 g0 = {bflo(gv.x), bfhi(gv.x), bflo(gv.y), bfhi(gv.y)}, g1 = {bflo(gv.z), bfhi(gv.z), bflo(gv.w), bfhi(gv.w)};
          *(u32x4*)p = pack8(acc[ai][bj][m][0] * ps0 * g0, acc[ai][bj][m][1] * ps1 * g1);
        }
    }
  }
};
struct EpiResid {
  static constexpr bool PERM = false;
  const float* src; float* dst; const float* gate;
  DI void operator()(const AccT& acc, const Unit& u, int wr, int wc, int fr, int fq) const {
    const int row0 = u.pm * 256 + wr * 64 + fr, col0 = u.pn * 256 + wc * 32 + 4 * fq, b = (u.pm * 256) >> 11;
#pragma unroll
    for (int bj = 0; bj < 2; ++bj)
#pragma unroll
      for (int n = 0; n < 2; ++n) {
        const int col = col0 + bj * 128 + n * 16;
        const f32x4 gt = *(const f32x4*)(gate + b * 1024 + col);
#pragma unroll
        for (int ai = 0; ai < 2; ++ai)
#pragma unroll
          for (int m = 0; m < 4; ++m) {
            const size_t o = (size_t)(row0 + ai * 128 + m * 16) * 1024 + col;
            *(f32x4*)(dst + o) = *(const f32x4*)(src + o) + gt * acc[ai][bj][m][n];
          }
      }
  }
};
struct EpiResidX {
  static constexpr bool PERM = false;
  const float* src; float* dst; const float* gate; const float* gs1; u16* xg; float* rowss;
  DI void operator()(const AccT& acc, const Unit& u, int wr, int wc, int fr, int fq) const {
    const int row0 = u.pm * 256 + wr * 64 + fr, col0 = u.pn * 256 + wc * 32 + 4 * fq, b = (u.pm * 256) >> 11;
    float ss[2][4];
#pragma unroll
    for (int ai = 0; ai < 2; ++ai)
#pragma unroll
      for (int m = 0; m < 4; ++m) ss[ai][m] = 0.f;
#pragma unroll
    for (int bj = 0; bj < 2; ++bj)
#pragma unroll
      for (int n = 0; n < 2; ++n) {
        const int col = col0 + bj * 128 + n * 16;
        const f32x4 gt = *(const f32x4*)(gate + b * 1024 + col), g1 = *(const f32x4*)(gs1 + b * 1024 + col);
#pragma unroll
        for (int ai = 0; ai < 2; ++ai)
#pragma unroll
          for (int m = 0; m < 4; ++m) {
            const size_t o = (size_t)(row0 + ai * 128 + m * 16) * 1024 + col;
            const f32x4 v = *(const f32x4*)(src + o) + gt * acc[ai][bj][m][n];
            *(f32x4*)(dst + o) = v;
            ss[ai][m] += (v[0] * v[0] + v[1] * v[1]) + (v[2] * v[2] + v[3] * v[3]);
            const f32x4 w = v * g1;
            u32x2 pw; pw.x = pk2(w[0], w[1]); pw.y = pk2(w[2], w[3]);
            *(u32x2*)(xg + o) = pw;
          }
      }
    const int ln = fq * 16 + fr, p16 = (ln ^ 16) * 4, p32 = (ln ^ 32) * 4;
#pragma unroll
    for (int ai = 0; ai < 2; ++ai)
#pragma unroll
      for (int m = 0; m < 4; ++m) {
        float t = ss[ai][m]; t += bperm(p16, t); t += bperm(p32, t);
        if (fq == 0) atomicAdd(rowss + row0 + ai * 128 + m * 16, t);
      }
  }
};
struct EpiCvec {
  static constexpr bool PERM = false;
  float* cvec;
  DI void operator()(const AccT& acc, const Unit& u, int wr, int wc, int fr, int fq) const {
    if (wr != 0) return;
    const int col0 = u.pn * 256 + wc * 32 + 4 * fq;
#pragma unroll
    for (int bj = 0; bj < 2; ++bj)
#pragma unroll
      for (int n = 0; n < 2; ++n) *(f32x4*)(cvec + (size_t)fr * 8192 + col0 + bj * 128 + n * 16) = acc[0][bj][0][n];
  }
};
struct EpiG1 {
  static constexpr bool PERM = true;
  u16* O; int ldc; const float* rowss; const float* cvec; int fbase;
  DI void operator()(const AccT& acc, const Unit& u, int wr, int wc, int fr, int fq) const {
    const int row0 = u.pm * 256 + wr * 64 + fr, col0 = u.pn * 256 + wc * 32 + 8 * fq, b = (u.pn * 256) >> 11;
    f32x4 r0[2], r1[2];
#pragma unroll
    for (int bj = 0; bj < 2; ++bj) {
      const f32x4 a = *(const f32x4*)(rowss + col0 + bj * 128), c = *(const f32x4*)(rowss + col0 + bj * 128 + 4);
#pragma unroll
      for (int e = 0; e < 4; ++e) { r0[bj][e] = rsqrtf(a[e] * (1.f / 1024.f) + 1e-6f); r1[bj][e] = rsqrtf(c[e] * (1.f / 1024.f) + 1e-6f); }
    }
#pragma unroll
    for (int ai = 0; ai < 2; ++ai)
#pragma unroll
      for (int m = 0; m < 4; ++m) {
        const int f = row0 + ai * 128 + m * 16;
        const float cv = cvec[(size_t)b * 8192 + fbase + f];
#pragma unroll
        for (int bj = 0; bj < 2; ++bj)
          *(u32x4*)(O + (size_t)f * ldc + col0 + bj * 128) = pack8(acc[ai][bj][m][0] * r0[bj] + cv, acc[ai][bj][m][1] * r1[bj] + cv);
      }
  }
};
struct EpiPlain {
  static constexpr bool PERM = true;
  u16* O; int ldc;
  DI void operator()(const AccT& acc, const Unit& u, int wr, int wc, int fr, int fq) const {
    const int row0 = u.pm * 256 + wr * 64 + fr, col0 = u.pn * 256 + wc * 32 + 8 * fq;
#pragma unroll
    for (int ai = 0; ai < 2; ++ai)
#pragma unroll
      for (int m = 0; m < 4; ++m)
#pragma unroll
        for (int bj = 0; bj < 2; ++bj)
          *(u32x4*)(O + (size_t)(row0 + ai * 128 + m * 16) * ldc + col0 + bj * 128) = pack8(acc[ai][bj][m][0], acc[ai][bj][m][1]);
  }
};

template <class Epi>
DI void run_gemm(int wv, LAS unsigned char* lds, const u16* A, int lda, const u16* Bt, int ldb, int M, int N, int K, int coff, const Epi& E) {
  asm volatile("" : "+s"(K));
  pg8::Gemm g; g.A = A; g.Bt = Bt; g.M = M; g.N = N; g.K = K; g.lda = lda; g.ldb = ldb;
  pg8::StaticOrder S; S.init(M, N, (int)gridDim.x, (int)((blockIdx.x + coff) % gridDim.x));
  pg8::gemm_phase<Epi>(lds, g, S, E, wv);
  __syncthreads();
}

DI void tr_item(const float* W, int K, int N, u16* WT, int k0, int n0, int drow0, LAS float* scr, int lane) {
#pragma unroll
  for (int i = 0; i < 32; ++i) { const int kk = 2 * i + (lane >> 5); scr[kk * 33 + (lane & 31)] = W[(size_t)(k0 + kk) * N + n0 + (lane & 31)]; }
  __builtin_amdgcn_wave_barrier();
  const int c = lane & 7;
#pragma unroll
  for (int j = 0; j < 4; ++j) { const int n = (lane >> 3) + 8 * j; const LAS float* s = scr + (8 * c) * 33 + n;
    u32x4 o; o.x = pk2(s[0 * 33], s[1 * 33]); o.y = pk2(s[2 * 33], s[3 * 33]); o.z = pk2(s[4 * 33], s[5 * 33]); o.w = pk2(s[6 * 33], s[7 * 33]);
    *(u32x4*)(WT + (size_t)(drow0 + n) * K + k0 + 8 * c) = o; }
  __builtin_amdgcn_wave_barrier();
}

DI void phase0(const Params& p, LAS unsigned char* lds, int wv) {
  const int lane = lane_id(), wave = wv, tid = wv * 64 + lane, bid = blockIdx.x, G = gridDim.x;
  unsigned char* ws = p.ws;
  {
    LAS float* sc = (LAS float*)lds;
    for (int item = bid; item < 96; item += G) {
      const int l = item / 48, r2 = item % 48, ks = r2 / 6, cb = r2 % 6;
      __syncthreads();
      for (int i = tid; i < 17 * 128; i += 512) { const int rr = i >> 7, k = ks * 128 + (i & 127); const float cv = rr < 16 ? p.in[I_C][rr * 1024 + k] : p.in[I_CCTX][k]; sc[i] = silu_f(cv); }
      __syncthreads();
      const int j = cb * 512 + tid;
      float a[17];
#pragma unroll
      for (int rr = 0; rr < 17; ++rr) a[rr] = 0.f;
      const float* W = p.in[I_ADAW] + (size_t)l * 1024 * 3072 + (size_t)(ks * 128) * 3072 + j;
#pragma unroll 16
      for (int kk = 0; kk < 128; ++kk) { const float w = W[(size_t)kk * 3072];
#pragma unroll
        for (int rr = 0; rr < 17; ++rr) a[rr] += sc[rr * 128 + kk] * w; }
      float* o = (float*)(ws + WS_ADAP) + (size_t)((l * 8 + ks) * 17) * 3072 + j;
#pragma unroll
      for (int rr = 0; rr < 17; ++rr) o[(size_t)rr * 3072] = a[rr];
    }
    __syncthreads();
  }
  if (bid == G - 1) {
    float* rope = (float*)(ws + WS_ROPE);
    for (int i = tid; i < 1024; i += 512) { const int pos = i >> 4, jj = i & 15; const float inv = powf(10000.f, -(float)jj / 16.f), ang = (float)pos * inv; rope[i] = cosf(ang); rope[1024 + i] = sinf(ang); }
  }
  {
    LAS float* mw = (LAS float*)(lds + 71680);
    __syncthreads();
#pragma unroll
    for (int q = 0; q < 5; ++q) { const int i = tid + 512 * q; if (i < 2112) mw[i] = p.in[I_FW0][i]; }
#pragma unroll
    for (int q = 0; q < 8; ++q) { const int i = tid + 512 * q; mw[2112 + i] = p.in[I_FW1][i]; mw[6208 + i] = p.in[I_FW2][i]; }
    __syncthreads();
    for (int t = bid * 8 + wave; t < SEQ; t += G * 8) {
      const float tl = (float)t / 2047.f, w = 6.283185307179586f * (float)t / 2048.f;
      float zv = 0.f;
      if (lane == 0) zv = tl;
      else if (lane < 33) { const int i = (lane - 1) & 15; const float band = 1e-4f + (float)i * ((15.f - 1e-4f) / 15.f); zv = lane < 17 ? cosf(band * w) : -sinf(band * w); }
      float a = 0.f;
#pragma unroll
      for (int i = 0; i < 33; ++i) a += __uint_as_float(__builtin_amdgcn_readlane(__float_as_uint(zv), i)) * mw[i * 64 + lane];
      float h = sinf(p.in[I_FF0][lane] * (a + p.in[I_FB0][lane]));
      a = 0.f;
#pragma unroll
      for (int i = 0; i < 64; ++i) a += __uint_as_float(__builtin_amdgcn_readlane(__float_as_uint(h), i)) * mw[2112 + i * 64 + lane];
      h = sinf(p.in[I_FF1][lane] * (a + p.in[I_FB1][lane]));
      a = 0.f;
#pragma unroll
      for (int i = 0; i < 64; ++i) a += __uint_as_float(__builtin_amdgcn_readlane(__float_as_uint(h), i)) * mw[6208 + i * 64 + lane];
      h = sinf(p.in[I_FF2][lane] * (a + p.in[I_FB2][lane]));
      ((float*)(ws + WS_H3))[t * 64 + lane] = h;
    }
  }
  {
    u16* WPB = (u16*)(ws + WS_G);
    for (int i = bid * 512 + tid; i < 1024 * 256; i += G * 512) { const int k = i >> 8, c4 = i & 255;
      const f32x4 v = *(const f32x4*)(p.in[I_AWIN] + (size_t)k * 6144 + 3072 + c4 * 4);
      u32x2 w; w.x = pk2(v[0], v[1]); w.y = pk2(v[2], v[3]);
      *(u32x2*)(WPB + (size_t)k * 1024 + c4 * 4) = w; }
  }
  {
    LAS float* scr = (LAS float*)lds + wave * (64 * 33);
    constexpr int I_A = 16 * 192, I_AO = 32 * 32, I_P = 128, I_H = 16 * 256, I_HO = 32 * 32, NIT = I_A + I_AO + I_P + I_H + I_HO;
    for (int it = bid * 8 + wave; it < NIT; it += G * 8) {
      int r = it;
      if (r < I_A) { const int kb = r / 192, nb = r % 192, n0 = nb * 32; const int drow = n0 < 2048 ? n0 : (n0 < 3072 ? n0 + 3072 : n0 - 1024);
        tr_item(p.in[I_AWIN], 1024, 6144, (u16*)(ws + WS_WA), kb * 64, n0, drow, scr, lane); continue; } r -= I_A;
      if (r < I_AO) { const int kb = r / 32, nb = r % 32; tr_item(p.in[I_AWOUT], 2048, 1024, (u16*)(ws + WS_WAO), kb * 64, nb * 32, nb * 32, scr, lane); continue; } r -= I_AO;
      if (r < I_P) { const int g = r / 32, q = r % 32, kb = q / 8, nb = q % 8; tr_item(p.in[I_POOLW] + g * 65536, 256, 256, (u16*)(ws + WS_PW) + g * 65536, kb * 64, nb * 32, nb * 32, scr, lane); continue; } r -= I_P;
      if (r < I_H) { const int kb = r / 256, nb = r % 256, n0 = nb * 32; const int part = n0 >> 11, c = n0 & 2047; const int drow = (c >> 9) * 2048 + part * 512 + (c & 511);
        tr_item(p.in[I_HWIN], 1024, 8192, (u16*)(ws + WS_WH), kb * 64, n0, drow, scr, lane); continue; } r -= I_H;
      { const int kb = r / 32, nb = r % 32; tr_item(p.in[I_HWOUT], 2048, 1024, (u16*)(ws + WS_WHO), kb * 64, nb * 32, nb * 32, scr, lane); }
    }
  }
}

DI void mod_vectors(const Params& p, int wv, int l, int r, LAS float* gs, LAS float* sh, float* gate_out) {
  const float* adaP = (const float*)(p.ws + WS_ADAP);
  for (int j = OTID(wv); j < 1024; j += 512) {
    float s0 = p.in[I_ADAB][l * 3072 + j], s1 = p.in[I_ADAB][l * 3072 + 1024 + j], s2 = p.in[I_ADAB][l * 3072 + 2048 + j];
#pragma unroll
    for (int ks = 0; ks < 8; ++ks) { const float* a = adaP + (size_t)((l * 8 + ks) * 17 + r) * 3072 + j; s0 += a[0]; s1 += a[1024]; s2 += a[2048]; }
    sh[j] = s0; gs[j] = p.in[I_NORMG][l * 1024 + j] * (1.f + s1);
    if (gate_out) gate_out[j] = s2;
  }
}
DI void mod_row(const float* xrow, u16* orow, const LAS float* gs, const LAS float* sh, int lane) {
  f32x4 v[4]; float ss = 0.f;
#pragma unroll
  for (int j = 0; j < 4; ++j) { v[j] = *(const f32x4*)(xrow + 4 * lane + 256 * j); ss += (v[j][0] * v[j][0] + v[j][1] * v[j][1]) + (v[j][2] * v[j][2] + v[j][3] * v[j][3]); }
  const float rstd = rsqrtf(wave_sum(ss) * (1.f / 1024.f) + 1e-6f);
#pragma unroll
  for (int j = 0; j < 4; ++j) {
    const int c = 4 * lane + 256 * j;
    const f32x4 g4 = *(const LAS f32x4*)(gs + c), s4 = *(const LAS f32x4*)(sh + c);
    const f32x4 o = v[j] * rstd * g4 + s4;
    u32x2 w; w.x = pk2(o[0], o[1]); w.y = pk2(o[2], o[3]);
    *(u32x2*)(orow + c) = w;
  }
}

DI void phase1(const Params& p, LAS unsigned char* lds, int wv) {
  const int lane = lane_id(), wave = wv, tid = wv * 64 + lane, bid = blockIdx.x, G = gridDim.x;
  unsigned char* ws = p.ws;
  {
    const float* H3 = (const float*)(ws + WS_H3);
    const float* wout = p.in[I_FWOUT];
    u16* F = (u16*)(ws + WS_F);
    const float mind = -3.0701134573253945f, maxd = -15.350567286626973f;
    LAS float* Hs = (LAS float*)lds;
    LAS float* Wl = (LAS float*)(lds + 16384) + wave * 2048;
    for (int it = bid; it < 1024; it += G) {
      const int tb = it & 31, cs = it >> 5, t = tb * 64 + lane, colb = cs * 256 + wave * 32, dir = (colb >> 11) & 1, o = colb >> 12;
      __syncthreads();
#pragma unroll
      for (int q = 0; q < 2; ++q) { const int idx = tid + 512 * q, tt = idx >> 4, j4 = idx & 15;
        const f32x4 h4 = *(const f32x4*)(H3 + (size_t)(tb * 64 + tt) * 64 + j4 * 4);
        Hs[(4 * j4) * 64 + tt] = h4[0]; Hs[(4 * j4 + 1) * 64 + tt] = h4[1]; Hs[(4 * j4 + 2) * 64 + tt] = h4[2]; Hs[(4 * j4 + 3) * 64 + tt] = h4[3]; }
#pragma unroll
      for (int q = 0; q < 8; ++q) { const int j = q * 8 + (lane >> 3), c4 = lane & 7;
        *(LAS f32x4*)(Wl + j * 32 + c4 * 4) = *(const f32x4*)(wout + (size_t)j * 8192 + colb + c4 * 4); }
      __syncthreads();
      f32x4 acc[8];
#pragma unroll
      for (int c = 0; c < 8; ++c) acc[c] = (f32x4){0.f, 0.f, 0.f, 0.f};
#pragma unroll 4
      for (int j = 0; j < 64; ++j) {
        const float h = Hs[j * 64 + lane];
#pragma unroll
        for (int c = 0; c < 8; ++c) acc[c] += h * *(const LAS f32x4*)(Wl + j * 32 + c * 4);
      }
      const float tl = (float)t / 2047.f;
#pragma unroll
      for (int c = 0; c < 8; ++c)
#pragma unroll
        for (int e = 0; e < 4; ++e) {
          const int cch = (colb + c * 4 + e) & 2047;
          const float delta = fabsf(mind + (float)cch * ((maxd - mind) / 2047.f));
          const float val = acc[c][e] * expf(-tl * delta);
          u16* Fr = F + (size_t)(cch * 2 + o) * 4096;
          const int idx = dir == 0 ? 2047 - t : (t > 0 ? 2047 + t : 4095);
          Fr[idx] = (dir == 1 && t == 0) ? (u16)0 : (u16)(pk2(val, 0.f) & 0xffffu);
        }
    }
  }
  __syncthreads();
#pragma unroll 1
  for (int g = 0; g < 4; ++g) { EpiPlain E; E.O = (u16*)(ws + WS_WA) + (size_t)(2048 + g * 256) * 1024; E.ldc = 1024;
    run_gemm(wv, lds, (const u16*)(ws + WS_PW) + g * 65536, 256, (const u16*)(ws + WS_G) + g * 256, 1024, 256, 1024, 256, 256 - 4 * g, E); }
  {
    LAS float* gs = (LAS float*)lds; LAS float* sh = gs + 1024; LAS float* gsc = sh + 1024; LAS float* shc = gsc + 1024;
    const int b = bid >> 4;
    float* gate = (float*)(ws + WS_GATE);
    __syncthreads();
    mod_vectors(p, wv, 0, b, gs, sh, (bid & 15) == 0 ? gate + b * 1024 : nullptr);
    mod_vectors(p, wv, 0, 16, gsc, shc, nullptr);
    __syncthreads();
    if ((bid & 15) == 1) {
      LAS float* g1 = shc + 1024; LAS float* s1 = g1 + 1024;
      mod_vectors(p, wv, 1, b, g1, s1, gate + 16384 + b * 1024);
      __syncthreads();
      for (int j = tid; j < 1024; j += 512) { ((float*)(ws + WS_GS1))[b * 1024 + j] = g1[j]; ((u16*)(ws + WS_SH1B))[b * 1024 + j] = (u16)(pk2(s1[j], 0.f) & 0xffffu); }
    }
    if ((bid & 15) == 2) {
      u32x4* z = (u32x4*)((u16*)(ws + WS_SH1B) + (size_t)(16 + b * 15) * 1024);
      for (int j = tid; j < 15 * 128; j += 512) z[j] = (u32x4){0u, 0u, 0u, 0u};
    }
    for (int i = 0; i < 16; ++i) { const int row = bid * 128 + wave * 16 + i; mod_row(p.in[I_X] + (size_t)row * 1024, (u16*)(ws + WS_H) + (size_t)row * 1024, gs, sh, lane); }
    for (int i = 0; i < 2; ++i) { const int row = bid * 16 + wave * 2 + i; mod_row(p.in[I_CTX] + (size_t)row * 1024, (u16*)(ws + WS_HC) + (size_t)row * 1024, gsc, shc, lane); }
    __syncthreads();
  }
}

DI void pool_means(const Params& p, int wv) {
  const u16* P = (const u16*)((unsigned char*)p.out + 64 * MB);
  u16* G = (u16*)(p.ws + WS_G); const float* pscale = p.in[I_POOLS];
  for (int gid = blockIdx.x * 512 + OTID(wv); gid < NB * 64 * 128; gid += gridDim.x * 512) {
    const int ch = gid & 127, r = (gid >> 7) & 63, b = gid >> 13, gi = ch >> 5, hw = 1 << gi;
    const u16* base = P + (size_t)b * SEQ * 1024 + ch * 8;
    const int t0 = r * 32;
    const f32x4 ps0 = *(const f32x4*)(pscale + ch * 8), ps1 = *(const f32x4*)(pscale + ch * 8 + 4);
    float s[8];
#pragma unroll
    for (int e = 0; e < 8; ++e) s[e] = 0.f;
    for (int q = t0 - hw; q < t0 + hw; ++q) if (q >= 0 && q < SEQ) { const u32x4 v = *(const u32x4*)(base + (size_t)q * 1024);
      s[0] += bflo(v.x); s[1] += bfhi(v.x); s[2] += bflo(v.y); s[3] += bfhi(v.y); s[4] += bflo(v.z); s[5] += bfhi(v.z); s[6] += bflo(v.w); s[7] += bfhi(v.w); }
#pragma unroll 4
    for (int t = t0; t < t0 + 32; ++t) {
      const int lo = max(t - hw, 0), hi = min(t + hw, SEQ);
      const float inv = 1.f / (float)(hi - lo);
      const u32x4 c = *(const u32x4*)(base + (size_t)t * 1024);
      u16* gp = G + ((size_t)b * SEQ + t) * 2048 + 1024 + ch * 8;
      const u32x4 gv = *(const u32x4*)gp;
      u32x4 o;
      o.x = pk2((s[0] * inv - bflo(c.x)) * ps0[0] * bflo(gv.x), (s[1] * inv - bfhi(c.x)) * ps0[1] * bfhi(gv.x)); o.y = pk2((s[2] * inv - bflo(c.y)) * ps0[2] * bflo(gv.y), (s[3] * inv - bfhi(c.y)) * ps0[3] * bfhi(gv.y));
      o.z = pk2((s[4] * inv - bflo(c.z)) * ps1[0] * bflo(gv.z), (s[5] * inv - bfhi(c.z)) * ps1[1] * bfhi(gv.z)); o.w = pk2((s[6] * inv - bflo(c.w)) * ps1[2] * bflo(gv.w), (s[7] * inv - bfhi(c.w)) * ps1[3] * bfhi(gv.w));
      *(u32x4*)gp = o;
      if (t + hw < SEQ) { const u32x4 v = *(const u32x4*)(base + (size_t)(t + hw) * 1024);
        s[0] += bflo(v.x); s[1] += bfhi(v.x); s[2] += bflo(v.y); s[3] += bfhi(v.y); s[4] += bflo(v.z); s[5] += bfhi(v.z); s[6] += bflo(v.w); s[7] += bfhi(v.w); }
      if (t - hw >= 0) { const u32x4 v = *(const u32x4*)(base + (size_t)(t - hw) * 1024);
        s[0] -= bflo(v.x); s[1] -= bfhi(v.x); s[2] -= bflo(v.y); s[3] -= bfhi(v.y); s[4] -= bflo(v.z); s[5] -= bfhi(v.z); s[6] -= bflo(v.w); s[7] -= bfhi(v.w); }
    }
  }
}

constexpr int AT_KSTR = 144, AT_VSTR = 136, AT_K1 = 9216, AT_V = 18432, AT_STAGE = 35840;
#define MFMA32(a, b, c) __builtin_amdgcn_mfma_f32_32x32x16_bf16((a), (b), (c), 0, 0, 0)
template <bool ZS> DI void att_tile(const LAS unsigned char* st, int sub, int ql, int hh, const bf16x8 (&qf)[4], float nshift, f32x16 (&O)[4], float& l) {
  const LAS unsigned char* kb_ = st + sub * AT_K1 + ql * AT_KSTR + 16 * hh;
  const LAS unsigned char* vb_ = st + AT_V + ql * AT_VSTR + 8 * hh;
  f32x16 S[2];
#pragma unroll
  for (int kb = 0; kb < 2; ++kb) {
#pragma unroll
    for (int r = 0; r < 16; ++r) S[kb][r] = ZS ? 0.f : nshift;
#pragma unroll
    for (int ks = 0; ks < 4; ++ks) { const bf16x8 kf = *(const LAS bf16x8*)(kb_ + kb * (32 * AT_KSTR) + ks * 32); S[kb] = MFMA32(kf, qf[ks], S[kb]); }
  }
  float ps = 0.f;
#pragma unroll
  for (int kb = 0; kb < 2; ++kb)
#pragma unroll
    for (int r = 0; r < 16; ++r) { const float e = __builtin_amdgcn_exp2f(S[kb][r]); S[kb][r] = e; ps += e; }
  l += ps;
#pragma unroll
  for (int kb = 0; kb < 2; ++kb)
#pragma unroll
    for (int s2 = 0; s2 < 2; ++s2) {
      u32x4 pw; pw.x = pk2(S[kb][8 * s2], S[kb][8 * s2 + 1]); pw.y = pk2(S[kb][8 * s2 + 2], S[kb][8 * s2 + 3]); pw.z = pk2(S[kb][8 * s2 + 4], S[kb][8 * s2 + 5]); pw.w = pk2(S[kb][8 * s2 + 6], S[kb][8 * s2 + 7]);
      const bf16x8 pf = __builtin_bit_cast(bf16x8, pw);
#pragma unroll
      for (int blk = 0; blk < 4; ++blk) {
        const LAS unsigned char* va = vb_ + blk * (32 * AT_VSTR) + (32 * kb + 16 * s2) * 2;
        const u32x2 lo = *(const LAS u32x2*)va, hi = *(const LAS u32x2*)(va + 16);
        const u32x4 vw = {lo.x, lo.y, hi.x, hi.y};
        O[blk] = MFMA32(__builtin_bit_cast(bf16x8, vw), pf, O[blk]);
      }
    }
}
DI void attention_phase(const Params& p, LAS unsigned char* lds, int wv, bool dry = false) {
  const int lane = lane_id(), tid = wv * 64 + lane;
  const int sub = wv >> 2, qg = wv & 3, ql = lane & 31, hh = lane >> 5, px = (lane ^ 32) * 4;
  const u16* Qb = (const u16*)p.out; const u16* Kb = (const u16*)(p.ws + WS_K); const u16* Vtb = (const u16*)(p.ws + WS_VT); u16* G = (u16*)(p.ws + WS_G);
  float lam;
  { const float a = p.in[I_LQ1][lane] * p.in[I_LK1][lane], b2 = p.in[I_LQ2][lane] * p.in[I_LK2][lane]; lam = expf(wave_sum(a)) - expf(wave_sum(b2)) + 0.2f; }
  const int krow = tid >> 3, kc = tid & 7;
  const unsigned koff = (unsigned)(krow * 128 + kc * 16), voff = (unsigned)(krow * (KALL * 2) + kc * 16);
  for (int it = 0; it < 8; ++it) {
    const int xj = blockIdx.x >> 3, bh = it * 16 + (blockIdx.x & 7) * 2 + (xj >> 4), qblk = xj & 15, b = bh >> 3, h = bh & 7;
    const char* kbase = (const char*)(Kb + (size_t)(b * 16 + 2 * h) * KALL * 64);
    const char* vbase = (const char*)(Vtb + (size_t)(b * 8 + h) * 128 * KALL);
    const int qrow = qblk * 128 + qg * 32 + ql;
    const u16* qp = Qb + ((size_t)(b * 16 + 2 * h + sub) * SEQ + qrow) * 64 + 8 * hh;
    bf16x8 qf[4];
#pragma unroll
    for (int ks = 0; ks < 4; ++ks) qf[ks] = *(const bf16x8*)(qp + 16 * ks);
    float nshift;
    { const float* kp = (const float*)(p.ws + WS_KPART) + (b * 16 + 2 * h + sub) * 8;
      float k2 = 0.f;
#pragma unroll
      for (int e = 0; e < 8; ++e) k2 += kp[e];
      float q2 = 0.f;
#pragma unroll
      for (int ks = 0; ks < 4; ++ks)
#pragma unroll
        for (int e = 0; e < 8; ++e) { const float qv = bf1((u16)qf[ks][e]); q2 += qv * qv; }
      q2 += bperm(px, q2);
      nshift = -sqrtf(q2 * k2); }
    const bool zs = __builtin_amdgcn_ballot_w64(nshift < -100.f) == 0ull;
    u32x4 ra[4];
#define AT_LOAD(kt_) do { const char* kb_ = kbase + (size_t)(kt_) * 8192; const char* vb_ = vbase + (size_t)(kt_) * 128; \
      ra[0] = *(const u32x4*)(kb_ + koff); ra[1] = *(const u32x4*)(kb_ + (size_t)KALL * 128 + koff); ra[2] = *(const u32x4*)(vb_ + voff); ra[3] = *(const u32x4*)(vb_ + (size_t)64 * KALL * 2 + voff); } while (0)
#define AT_WRITE(sn_) do { LAS unsigned char* s_ = (sn_); \
      *(LAS u32x4*)(s_ + krow * AT_KSTR + kc * 16) = ra[0]; *(LAS u32x4*)(s_ + AT_K1 + krow * AT_KSTR + kc * 16) = ra[1]; \
      *(LAS u32x2*)(s_ + AT_V + krow * AT_VSTR + kc * 16) = (u32x2){ra[2].x, ra[2].y}; *(LAS u32x2*)(s_ + AT_V + krow * AT_VSTR + kc * 16 + 8) = (u32x2){ra[2].z, ra[2].w}; \
      *(LAS u32x2*)(s_ + AT_V + (64 + krow) * AT_VSTR + kc * 16) = (u32x2){ra[3].x, ra[3].y}; *(LAS u32x2*)(s_ + AT_V + (64 + krow) * AT_VSTR + kc * 16 + 8) = (u32x2){ra[3].z, ra[3].w}; } while (0)
    AT_LOAD(0);
    __syncthreads();
    AT_WRITE(lds);
    __syncthreads();
    f32x16 O[4];
#pragma unroll
    for (int blk = 0; blk < 4; ++blk)
#pragma unroll
      for (int r = 0; r < 16; ++r) O[blk][r] = 0.f;
    float l = 0.f;
    if (zs) {
      for (int kt = 0; kt < KALL / 64; ++kt) {
        const bool more = kt + 1 < KALL / 64;
        if (more) AT_LOAD(kt + 1);
        att_tile<true>(lds + (kt & 1) * AT_STAGE, sub, ql, hh, qf, 0.f, O, l);
        if (more) AT_WRITE(lds + ((kt + 1) & 1) * AT_STAGE);
        __syncthreads();
      }
    } else {
      for (int kt = 0; kt < KALL / 64; ++kt) {
        const bool more = kt + 1 < KALL / 64;
        if (more) AT_LOAD(kt + 1);
        att_tile<false>(lds + (kt & 1) * AT_STAGE, sub, ql, hh, qf, nshift, O, l);
        if (more) AT_WRITE(lds + ((kt + 1) & 1) * AT_STAGE);
        __syncthreads();
      }
    }
#undef AT_LOAD
#undef AT_WRITE
    l += bperm(px, l);
    const float invl = 1.f / l;
    LAS float* X = (LAS float*)lds + qg * 4096;
    if (sub == 1) {
#pragma unroll
      for (int blk = 0; blk < 4; ++blk)
#pragma unroll
        for (int r = 0; r < 16; ++r) { const int dv = 32 * blk + (r & 3) + 8 * (r >> 2) + 4 * hh; X[dv * 32 + ql] = O[blk][r] * invl; }
    }
    __syncthreads();
    if (sub == 0) {
      float ss = 0.f;
#pragma unroll
      for (int blk = 0; blk < 4; ++blk)
#pragma unroll
        for (int r = 0; r < 16; ++r) { const int dv = 32 * blk + (r & 3) + 8 * (r >> 2) + 4 * hh; const float o = O[blk][r] * invl - lam * X[dv * 32 + ql]; O[blk][r] = o; ss += o * o; }
      ss += bperm(px, ss);
      const float rinv = rsqrtf(ss * (1.f / 128.f) + 1e-5f) * 0.8f;
      u16* grow = G + (size_t)(b * SEQ + qrow) * 2048 + h * 128;
#pragma unroll
      for (int blk = 0; blk < 4; ++blk)
#pragma unroll
        for (int g4 = 0; g4 < 4; ++g4) {
          const int dv = 32 * blk + 8 * g4 + 4 * hh;
          const f32x4 sg = *(const f32x4*)(p.in[I_SUBLN] + dv);
          const u32x2 gg = *(const u32x2*)(grow + dv);
          u32x2 o;
          o.x = pk2(O[blk][4 * g4] * rinv * sg[0] * bflo(gg.x), O[blk][4 * g4 + 1] * rinv * sg[1] * bfhi(gg.x));
          o.y = pk2(O[blk][4 * g4 + 2] * rinv * sg[2] * bflo(gg.y), O[blk][4 * g4 + 3] * rinv * sg[3] * bfhi(gg.y));
          if (dry) *(u32x2*)((u16*)(p.ws + WS_HC) + (size_t)(b * SEQ + qrow) * 128 + dv) = o; else *(u32x2*)(grow + dv) = o;
        }
    }
  }
  __syncthreads();
}

constexpr int CV_USTR = 4112;
constexpr int CV_FL = 66048;
constexpr int CV_FW = 2064;
DI void toeplitz_mma(f32x4 (&acc)[16], const LAS unsigned* FLo, const LAS unsigned char* U, int wv, int lane) {
  const int i = lane & 15, kq = lane >> 4;
  const int base = 2047 - 256 * wv - i + 8 * kq;
  const LAS unsigned* fl = FLo + (base & 1) * CV_FW + (base >> 1);
  const LAS unsigned char* ub = U + i * CV_USTR + kq * 16;
  bf16x8 win[16];
#pragma unroll
  for (int a = 0; a < 16; ++a) { const LAS unsigned* q = fl - 8 * a; u32x4 w = {q[0], q[1], q[2], q[3]}; win[a] = __builtin_bit_cast(bf16x8, w); }
  for (int so = 0; so < 8; ++so) {
#pragma unroll
    for (int si = 0; si < 8; ++si) {
      const int sg = so * 8 + si;
      const bf16x8 bfr = *(const LAS bf16x8*)(ub + 64 * sg);
      const LAS unsigned* q0 = fl + 16 * sg + 16; const LAS unsigned* q1 = fl + 16 * sg + 8;
      const u32x4 w0 = {q0[0], q0[1], q0[2], q0[3]}, w1 = {q1[0], q1[1], q1[2], q1[3]};
#pragma unroll
      for (int a = 0; a < 16; ++a) acc[a] = __builtin_amdgcn_mfma_f32_16x16x32_bf16(win[(a - 2 * si + 16) & 15], bfr, acc[a], 0, 0, 0);
      win[(-2 * si - 2 + 32) & 15] = __builtin_bit_cast(bf16x8, w0);
      win[(-2 * si - 1 + 32) & 15] = __builtin_bit_cast(bf16x8, w1);
    }
  }
}
DI f32x4 sconv4(const u16* row, int t, float w0, float w1, float w2, float cb) {
  const u32x2 c = *(const u32x2*)(row + t);
  const float xm = t > 0 ? bf1(row[t - 1]) : 0.f, xp = t + 4 < SEQ ? bf1(row[t + 4]) : 0.f;
  const float x0 = bflo(c.x), x1 = bfhi(c.x), x2 = bflo(c.y), x3 = bfhi(c.y);
  f32x4 r; r[0] = cb + w0 * xm + w1 * x0 + w2 * x1; r[1] = cb + w0 * x0 + w1 * x1 + w2 * x2; r[2] = cb + w0 * x1 + w1 * x2 + w2 * x3; r[3] = cb + w0 * x2 + w1 * x3 + w2 * xp;
  return r;
}
constexpr int CV_X = 65792;
constexpr int CV_FL1 = 131584;
DI void conv_load_row(const u16* row, const u16* grow, LAS unsigned char* dst, float w0, float w1, float w2, float cb, int tid) {
  u32x4 cur[8], gt[8]; unsigned hm[8], hp[8];
  const bool first = (tid & 255) == 0, last = (tid & 255) == 255;
  const u16* r = row + (size_t)tid * 8;
#pragma unroll
  for (int kj = 0; kj < 8; ++kj) {
    const u16* rk = r + (size_t)kj * 4096;
    cur[kj] = *(const u32x4*)rk;
    hm[kj] = first ? 0u : (unsigned)rk[-1];
    hp[kj] = last ? 0u : (unsigned)rk[8];
  }
  if (grow) {
    const u16* g = grow + (size_t)tid * 8;
#pragma unroll
    for (int kj = 0; kj < 8; ++kj) gt[kj] = *(const u32x4*)(g + (size_t)kj * 4096);
  }
#pragma unroll
  for (int kj = 0; kj < 8; ++kj) {
    const int k = tid + 512 * kj, b = k >> 8, t0 = (k & 255) * 8;
    const u32x4 c4 = cur[kj];
    float x[10]; x[0] = __uint_as_float(hm[kj] << 16); x[1] = bflo(c4.x); x[2] = bfhi(c4.x); x[3] = bflo(c4.y); x[4] = bfhi(c4.y); x[5] = bflo(c4.z); x[6] = bfhi(c4.z); x[7] = bflo(c4.w); x[8] = bfhi(c4.w); x[9] = __uint_as_float(hp[kj] << 16);
    float y[8];
#pragma unroll
    for (int e = 0; e < 8; ++e) y[e] = cb + w0 * x[e] + w1 * x[e + 1] + w2 * x[e + 2];
    if (grow) { const u32x4 g = gt[kj];
      y[0] *= silu_f(bflo(g.x)); y[1] *= silu_f(bfhi(g.x)); y[2] *= silu_f(bflo(g.y)); y[3] *= silu_f(bfhi(g.y)); y[4] *= silu_f(bflo(g.z)); y[5] *= silu_f(bfhi(g.z)); y[6] *= silu_f(bflo(g.w)); y[7] *= silu_f(bfhi(g.w)); }
    u32x4 o; o.x = pk2(y[0], y[1]); o.y = pk2(y[2], y[3]); o.z = pk2(y[4], y[5]); o.w = pk2(y[6], y[7]);
    *(LAS u32x4*)(dst + b * CV_USTR + t0 * 2) = o;
  }
}
DI void conv_load_filter(const u16* Fco, LAS unsigned* FLw, int tid) {
  const unsigned* Fg = (const unsigned*)Fco;
#pragma unroll
  for (int kj = 0; kj < 4; ++kj) { const int k = tid + 512 * kj; const unsigned w0 = Fg[k], w1 = (k + 1 < 2048) ? Fg[k + 1] : 0u;
    FLw[k] = w0; FLw[CV_FW + k] = (w0 >> 16) | (w1 << 16); }
  if (tid < 16) { FLw[2048 + tid] = 0u; FLw[CV_FW + 2048 + tid] = 0u; }
}
DI void conv_phase(const Params& p, LAS unsigned char* lds, int grp, int wv) {
  const int lane = lane_id(), tid = wv * 64 + lane;
  const u16* Ut = (const u16*)(p.ws + WS_UT);
  const u16* F = (const u16*)(p.ws + WS_F);
  u16* Zt = (u16*)(p.ws + WS_ZT);
  LAS unsigned* FLw = (LAS unsigned*)(lds + CV_FL1);
  const float* cw = p.in[I_CONVW]; const float* cbp = p.in[I_CONVB]; const float* fb = p.in[I_FBIAS];
  for (int ci = 0; ci < 2; ++ci) {
    const int cc = blockIdx.x * 2 + ci, c = grp * 512 + cc;
    __syncthreads();
    conv_load_filter(F + (size_t)(c * 2) * 4096, FLw, tid);
    conv_load_row(Ut + (size_t)cc * NTOK, nullptr, lds, cw[c], cw[6144 + c], cw[2 * 6144 + c], cbp[c], tid);
    conv_load_row(Ut + (size_t)(512 + cc) * NTOK, nullptr, lds + CV_X, cw[2048 + c], cw[6144 + 2048 + c], cw[2 * 6144 + 2048 + c], cbp[2048 + c], tid);
    __syncthreads();
    f32x4 acc[16];
#pragma unroll
    for (int a = 0; a < 16; ++a) acc[a] = (f32x4){0.f, 0.f, 0.f, 0.f};
    toeplitz_mma(acc, FLw, lds, wv, lane);
    {
      const int l2 = lane_id(), b = l2 & 15, kq = l2 >> 4;
      const float bias = fb[c];
#pragma unroll
      for (int a = 0; a < 16; ++a) {
        const int t = 256 * wv + 16 * a + 4 * kq;
        const u32x2 uu = *(const LAS u32x2*)(lds + b * CV_USTR + t * 2), xx = *(const LAS u32x2*)(lds + CV_X + b * CV_USTR + t * 2);
        const f32x4 u4 = {bflo(uu.x), bfhi(uu.x), bflo(uu.y), bfhi(uu.y)}, x4 = {bflo(xx.x), bfhi(xx.x), bflo(xx.y), bfhi(xx.y)};
        acc[a] = x4 * (acc[a] + bias * u4);
      }
    }
    __syncthreads();
    { const int l2 = lane_id(), b = l2 & 15, kq = l2 >> 4;
#pragma unroll
      for (int a = 0; a < 16; ++a) {
        const int t = 256 * wv + 16 * a + 4 * kq;
        u32x2 o; o.x = pk2(acc[a][0], acc[a][1]); o.y = pk2(acc[a][2], acc[a][3]);
        *(LAS u32x2*)(lds + b * CV_USTR + t * 2) = o;
        acc[a] = (f32x4){0.f, 0.f, 0.f, 0.f};
      } }
    { const int t2 = wv * 64 + lane_id();
      conv_load_filter(F + (size_t)(c * 2 + 1) * 4096, FLw, t2);
      conv_load_row(Ut + (size_t)(1024 + cc) * NTOK, Ut + (size_t)(1536 + cc) * NTOK, lds + CV_X, cw[4096 + c], cw[6144 + 4096 + c], cw[2 * 6144 + 4096 + c], cbp[4096 + c], t2); }
    __syncthreads();
    toeplitz_mma(acc, FLw, lds, wv, lane);
    {
      const int l2 = lane_id(), b = l2 & 15, kq = l2 >> 4;
      const float bias = fb[2048 + c];
#pragma unroll
      for (int a = 0; a < 16; ++a) {
        const int t = 256 * wv + 16 * a + 4 * kq;
        const u32x2 uu = *(const LAS u32x2*)(lds + b * CV_USTR + t * 2), xx = *(const LAS u32x2*)(lds + CV_X + b * CV_USTR + t * 2);
        const f32x4 z4 = {bflo(uu.x), bfhi(uu.x), bflo(uu.y), bfhi(uu.y)}, x4 = {bflo(xx.x), bfhi(xx.x), bflo(xx.y), bfhi(xx.y)};
        const f32x4 r = x4 * (acc[a] + bias * z4);
        u32x2 o; o.x = pk2(r[0], r[1]); o.y = pk2(r[2], r[3]);
        *(LAS u32x2*)(lds + CV_X + b * CV_USTR + t * 2) = o;
      }
    }
    __syncthreads();
    { const int t2 = wv * 64 + lane_id();
      u16* zrow = Zt + (size_t)c * NTOK;
#pragma unroll
      for (int kj = 0; kj < 8; ++kj) { const int k = t2 + 512 * kj, b = k >> 8, t0 = (k & 255) * 8;
        *(u32x4*)(zrow + (size_t)k * 8) = *(const LAS u32x4*)(lds + CV_X + b * CV_USTR + t0 * 2); } }
  }
  __syncthreads();
}

DI void transpose_phase(const Params& p, LAS unsigned char* lds, int wv) {
  const int lane = lane_id(), wave = wv;
  const u16* Zt = (const u16*)(p.ws + WS_ZT); u16* Z = (u16*)(p.ws + WS_Z);
  LAS unsigned char* scr = lds + wave * (64 * 144);
  for (int it = blockIdx.x * 8 + wave; it < 32 * 512; it += gridDim.x * 8) {
    const int cb = it & 31, tb = it >> 5, c0 = cb * 64, tok0 = tb * 64;
#pragma unroll
    for (int i = 0; i < 8; ++i) { const int cr = (lane >> 3) + 8 * i, tc = lane & 7;
      *(LAS u32x4*)(scr + cr * 144 + tc * 16) = *(const u32x4*)(Zt + (size_t)(c0 + cr) * NTOK + tok0 + tc * 8); }
    __builtin_amdgcn_wave_barrier();
#pragma unroll
    for (int i = 0; i < 8; ++i) { const int tk = (lane >> 3) + 8 * i, cc = lane & 7;
      const LAS u16* s = (const LAS u16*)(scr + (cc * 8) * 144 + tk * 2);
      u32x4 o;
      o.x = (unsigned)s[0] | ((unsigned)s[72] << 16); o.y = (unsigned)s[144] | ((unsigned)s[216] << 16);
      o.z = (unsigned)s[288] | ((unsigned)s[360] << 16); o.w = (unsigned)s[432] | ((unsigned)s[504] << 16);
      *(u32x4*)(Z + (size_t)(tok0 + tk) * 2048 + c0 + cc * 8) = o; }
    __builtin_amdgcn_wave_barrier();
  }
}

#define GS() do { ep += gridDim.x; gsync(bar, ep, wv); } while (0)
__global__ void __launch_bounds__(512, 2) fwd_megakernel(Params p) {
  extern __shared__ __attribute__((aligned(16))) unsigned char shm[];
  LAS unsigned char* lds = (LAS unsigned char*)shm;
  const int wv = __builtin_amdgcn_readfirstlane((int)threadIdx.x >> 6);
  cg::this_grid().sync();
  unsigned char* ws = p.ws;
  unsigned* bar = (unsigned*)ws; unsigned ep = 0;
  const int bid = blockIdx.x;
  u16* Qb = (u16*)p.out; u16* Pb = (u16*)((unsigned char*)p.out + 64 * MB);
  float* gate = (float*)(ws + WS_GATE);

  phase0(p, lds, wv);
  GS();
  phase1(p, lds, wv);
  GS();
  { EpiL0Main E; E.Q = Qb; E.K = (u16*)(ws + WS_K); E.P = Pb; E.G = (u16*)(ws + WS_G); E.rope = (const float*)(ws + WS_ROPE); E.kpart = (unsigned*)(ws + WS_KPART);
    run_gemm(wv, lds, (const u16*)(ws + WS_H), 1024, (const u16*)(ws + WS_WA), 1024, NTOK, 5120, 1024, 0, E);
#ifdef REP_G0
    run_gemm(wv, lds, (const u16*)(ws + WS_H), 1024, (const u16*)(ws + WS_WA), 1024, NTOK, 5120, 1024, 0, E);
#endif
  }
  { EpiVt E; E.Vt = (u16*)(ws + WS_VT); E.shift = 11; E.toff = CTXL;
    run_gemm(wv, lds, (const u16*)(ws + WS_WA) + (size_t)5120 * 1024, 1024, (const u16*)(ws + WS_H), 1024, 1024, NTOK, 1024, 0, E); }
  { EpiCtxK E; E.K = (u16*)(ws + WS_K); E.kpart = (unsigned*)(ws + WS_KPART);
    run_gemm(wv, lds, (const u16*)(ws + WS_HC), 1024, (const u16*)(ws + WS_WA) + (size_t)1024 * 1024, 1024, NCTX, 1024, 1024, 0, E); }
  { EpiVt E; E.Vt = (u16*)(ws + WS_VT); E.shift = 8; E.toff = 0;
    run_gemm(wv, lds, (const u16*)(ws + WS_WA) + (size_t)5120 * 1024, 1024, (const u16*)(ws + WS_HC), 1024, 1024, NCTX, 1024, 192, E); }
  { EpiCvec E; E.cvec = (float*)(ws + WS_CVEC);
    run_gemm(wv, lds, (const u16*)(ws + WS_SH1B), 1024, (const u16*)(ws + WS_WH), 1024, 256, 8192, 1024, 128, E); }
  GS();
  for (int i = bid * 512 + OTID(wv); i < NTOK; i += 256 * 512) ((float*)(ws + WS_ROWSS))[i] = 0.f;
  pool_means(p, wv);
#ifdef REP_ATT
  attention_phase(p, lds, wv, true);
#endif
  attention_phase(p, lds, wv);
  GS();
  { EpiResidX E; E.src = p.in[I_X]; E.dst = p.out; E.gate = gate; E.gs1 = (const float*)(ws + WS_GS1); E.xg = (u16*)(ws + WS_H); E.rowss = (float*)(ws + WS_ROWSS);
    run_gemm(wv, lds, (const u16*)(ws + WS_G), 2048, (const u16*)(ws + WS_WAO), 2048, NTOK, 1024, 2048, 0, E); }
  GS();
  for (int grp = 0; grp < 4; ++grp) {
    { EpiG1 E; E.O = (u16*)(ws + WS_UT); E.ldc = NTOK; E.rowss = (const float*)(ws + WS_ROWSS); E.cvec = (const float*)(ws + WS_CVEC); E.fbase = grp * 2048;
      run_gemm(wv, lds, (const u16*)(ws + WS_WH) + (size_t)grp * 2048 * 1024, 1024, (const u16*)(ws + WS_H), 1024, 2048, NTOK, 1024, 0, E);
#ifdef REP_G1
      run_gemm(wv, lds, (const u16*)(ws + WS_WH) + (size_t)grp * 2048 * 1024, 1024, (const u16*)(ws + WS_H), 1024, 2048, NTOK, 1024, 0, E);
#endif
    }
    GS();
    conv_phase(p, lds, grp, wv);
#ifdef REP_CONV
    conv_phase(p, lds, grp, wv);
#endif
    GS();
  }
  transpose_phase(p, lds, wv);
  GS();
  { EpiResid E; E.src = p.out; E.dst = p.out; E.gate = gate + 16384;
    run_gemm(wv, lds, (const u16*)(ws + WS_Z), 2048, (const u16*)(ws + WS_WHO), 2048, NTOK, 1024, 2048, 0, E); }
  GS();
  const int lane = lane_id(), wave = wv;
  for (int i = 0; i < 16; ++i) {
    const int row = bid * 128 + wave * 16 + i; float* xr = p.out + (size_t)row * 1024;
    f32x4 v[4]; float ss = 0.f;
#pragma unroll
    for (int j = 0; j < 4; ++j) { v[j] = *(const f32x4*)(xr + 4 * lane + 256 * j); ss += (v[j][0] * v[j][0] + v[j][1] * v[j][1]) + (v[j][2] * v[j][2] + v[j][3] * v[j][3]); }
    const float rstd = rsqrtf(wave_sum(ss) * (1.f / 1024.f) + 1e-6f);
#pragma unroll
    for (int j = 0; j < 4; ++j) { const f32x4 g4 = *(const f32x4*)(p.in[I_FINALG] + 4 * lane + 256 * j); *(f32x4*)(xr + 4 * lane + 256 * j) = v[j] * rstd * g4; }
  }
}

constexpr int LDS_BYTES = 148480;

extern "C" void kernel_launch(void* const* d_in, const int* in_sizes, int n_in, void* d_out, int out_size, void* d_ws, size_t ws_size, hipStream_t stream) {
  static int grid_blocks = 0;
  if (grid_blocks == 0) {
    if (n_in != 32 || out_size != NTOK * DM || ws_size < WS_END) { fprintf(stderr, "kernel_launch: unexpected shapes (n_in %d out %d ws %zu)\n", n_in, out_size, ws_size); grid_blocks = -1; return; }
    int dev = 0, cus = 0, per_cu = 0;
    hipGetDevice(&dev);
    hipDeviceGetAttribute(&cus, hipDeviceAttributeMultiprocessorCount, dev);
    if (hipFuncSetAttribute((const void*)fwd_megakernel, hipFuncAttributeMaxDynamicSharedMemorySize, LDS_BYTES) != hipSuccess) { fprintf(stderr, "hipFuncSetAttribute failed\n"); grid_blocks = -1; return; }
    hipOccupancyMaxActiveBlocksPerMultiprocessor(&per_cu, (const void*)fwd_megakernel, 512, LDS_BYTES);
    if (per_cu < 1 || cus < 256) { fprintf(stderr, "occupancy %d cus %d\n", per_cu, cus); grid_blocks = -1; return; }
    grid_blocks = 256;
  }
  if (grid_blocks < 0) return;
  if (hipMemsetAsync(d_ws, 0, WS_KPART + 8192, stream) != hipSuccess) { fprintf(stderr, "memset failed\n"); return; }
  Params p{};
  for (int i = 0; i < 32; ++i) p.in[i] = (const float*)d_in[i];
  p.out = (float*)d_out; p.ws = (unsigned char*)d_ws;
  void* args[] = {&p};
  hipError_t e = hipLaunchCooperativeKernel((void*)fwd_megakernel, dim3(grid_blocks), dim3(512), args, LDS_BYTES, stream);
  if (e != hipSuccess) fprintf(stderr, "cooperative launch failed: %s\n", hipGetErrorString(e));
}
```

```cpp
#include <hip/hip_runtime.h>
#include <hip/hip_cooperative_groups.h>
#include <cstdio>
#include <cstdint>
namespace cg = cooperative_groups;

#define DI __device__ __forceinline__
#define LAS __attribute__((address_space(3)))
typedef unsigned short u16;
typedef short bf16x8 __attribute__((ext_vector_type(8)));
typedef float f32x4 __attribute__((ext_vector_type(4)));
typedef float f32x2 __attribute__((ext_vector_type(2)));
typedef float f32x16 __attribute__((ext_vector_type(16)));
typedef unsigned u32x4 __attribute__((ext_vector_type(4)));
typedef unsigned u32x2 __attribute__((ext_vector_type(2)));
typedef __bf16 bf16x2_t __attribute__((ext_vector_type(2)));

DI unsigned pk2(float lo, float hi) { bf16x2_t v = __builtin_convertvector((f32x2){lo, hi}, bf16x2_t); return __builtin_bit_cast(unsigned, v); }
DI float bflo(unsigned w) { return __uint_as_float(w << 16); }
DI float bfhi(unsigned w) { return __uint_as_float(w & 0xffff0000u); }
DI float bf1(u16 h) { return __uint_as_float(((unsigned)h) << 16); }
DI float silu_f(float v) { return v * __builtin_amdgcn_rcpf(1.f + __builtin_amdgcn_exp2f(-1.4426950408889634f * v)); }
template <int M> DI float swz_xor(float v) { return __int_as_float(__builtin_amdgcn_ds_swizzle(__float_as_int(v), 0x1f | (M << 10))); }
DI float wave_sum(float v) {
  v += swz_xor<1>(v); v += swz_xor<2>(v); v += swz_xor<4>(v); v += swz_xor<8>(v); v += swz_xor<16>(v);
  return __uint_as_float(__builtin_amdgcn_readlane(__float_as_uint(v), 0)) + __uint_as_float(__builtin_amdgcn_readlane(__float_as_uint(v), 32));
}
DI float bperm(int idx4, float v) { return __int_as_float(__builtin_amdgcn_ds_bpermute(idx4, __float_as_int(v))); }

DI int lane_id() { int l; asm volatile("v_mbcnt_lo_u32_b32 %0, -1, 0\n\tv_mbcnt_hi_u32_b32 %0, -1, %0" : "=v"(l)); return l; }
#define OTID(wv) ((wv) * 64 + lane_id())
DI void gsync(unsigned* bar, unsigned target, int wv) {
  __syncthreads();
  if (wv == 0 && lane_id() == 0) {
    __hip_atomic_fetch_add(bar, 1u, __ATOMIC_RELEASE, __HIP_MEMORY_SCOPE_AGENT);
    while (__hip_atomic_load(bar, __ATOMIC_RELAXED, __HIP_MEMORY_SCOPE_AGENT) < target) __builtin_amdgcn_s_sleep(2);
    __builtin_amdgcn_fence(__ATOMIC_ACQUIRE, "agent");
  }
  __syncthreads();
}
constexpr int NB = 16, SEQ = 2048, DM = 1024, NTOK = NB * SEQ, CTXL = 256, NCTX = NB * CTXL, KALL = SEQ + CTXL;
constexpr size_t MB = 1024 * 1024;
constexpr size_t WS_ROPE = 4096;
constexpr size_t WS_GATE = 16384;
constexpr size_t WS_KPART = 147456;
constexpr size_t WS_ADAP = 256 * 1024;
constexpr size_t WS_H3 = 4 * MB;
constexpr size_t WS_WA = 5 * MB;
constexpr size_t WS_WAO = 17 * MB;
constexpr size_t WS_PW = 21 * MB;
constexpr size_t WS_WH = 22 * MB;
constexpr size_t WS_WHO = 38 * MB;
constexpr size_t WS_F = 42 * MB;
constexpr size_t WS_H = 74 * MB;
constexpr size_t WS_L = 138 * MB;
constexpr size_t WS_HC = WS_L;
constexpr size_t WS_K = WS_L + 8 * MB;
constexpr size_t WS_VT = WS_K + 72 * MB;
constexpr size_t WS_G = WS_VT + 72 * MB;
constexpr size_t WS_UT = WS_L;
constexpr size_t WS_ZT = WS_L + 128 * MB;
constexpr size_t WS_Z = WS_H;
constexpr size_t WS_END = 418 * MB;

struct Params { const float* in[32]; float* out; unsigned char* ws; };
enum { I_X = 0, I_C, I_CTX, I_CCTX, I_NORMG, I_ADAW, I_ADAB, I_FINALG, I_AWIN, I_LQ1, I_LK1, I_LQ2, I_LK2, I_SUBLN, I_POOLW, I_POOLS, I_AWOUT,
       I_HWIN, I_CONVW, I_CONVB, I_FW0, I_FB0, I_FF0, I_FW1, I_FB1, I_FF1, I_FW2, I_FB2, I_FF2, I_FWOUT, I_FBIAS, I_HWOUT };

namespace pg8 {
constexpr int BM = 256, BK = 64, HALF = 128, HTB = HALF * BK * 2, STAGE_BYTES = 8 * HTB, NXCD = 8, WGM = 8;
DI int lds_byte(int r, int c) { const int st = (r >> 4) * 2 + (c >> 5), rr = r & 15, cc = c & 31, ob = rr * 64 + cc * 2; return st * 1024 + (ob ^ (((ob >> 9) & 1) << 5)); }
DI void stage_rc(int b, int& R, int& C) { const int st = b / 1024, sb = b % 1024, swz = sb ^ (((sb >> 9) & 1) << 5); R = (st >> 1) * 16 + swz / 64; C = (st & 1) * 32 + (swz % 64) / 2; }
DI int perm32(int rho) { const int n = rho >> 4, i = rho & 15; return 8 * (i >> 2) + 4 * n + (i & 3); }
struct Unit { int pm, pn; };
struct Gemm { const u16* A; const u16* Bt; int M, N, K, lda, ldb; };
struct StaticOrder {
  int nM, nN, nwg, G, c;
  DI void init(int M, int N, int G_, int c_) { nM = M / BM; nN = N / BM; nwg = nM * nN; G = G_; c = c_; }
  DI bool next(int i, Unit& u) const {
    const long L = (long)i * G + c; if (L >= nwg) return false;
    int wgid = (int)L; { const int q = nwg / NXCD, r = nwg % NXCD, xcd = wgid % NXCD, off = wgid / NXCD; wgid = (xcd < r ? xcd * (q + 1) : r * (q + 1) + (xcd - r) * q) + off; }
    const int nig = WGM * nN, gid = wgid / nig, fm = gid * WGM, gsz = (nM - fm) < WGM ? (nM - fm) : WGM;
    u.pm = fm + ((wgid % nig) % gsz); u.pn = (wgid % nig) / gsz; return true;
  }
};
template <class Epi>
DI void gemm_phase(LAS unsigned char* lds, const Gemm g, const StaticOrder& S, const Epi& E, int wv) {
  const int wid = wv, lane = lane_id(), tid = wid * 64 + lane, wr = wid >> 2, wc = wid & 3, fr = lane & 15, fq = lane >> 4;
  const int K = g.K, nt = K / BK;
  unsigned voffA[2], voffB[2];
#pragma unroll
  for (int i = 0; i < 2; ++i) { int R, C; stage_rc(tid * 16 + i * 8192, R, C); const int Rb = Epi::PERM ? ((R & ~31) + perm32(R & 31)) : R;
    voffA[i] = (unsigned)(R * g.lda + C) * 2u; voffB[i] = (unsigned)(Rb * g.ldb + C) * 2u; }
  const size_t kstep = (size_t)(BK * 2);
  const size_t hstepA = (size_t)HALF * g.lda * 2, hstepB = (size_t)HALF * g.ldb * 2;
  const size_t tstepA = 2 * hstepA, tstepB = 2 * hstepB;
  const unsigned ldsw = (unsigned)wid * 1024u;
  const int aoff = lds_byte(wr * 64 + fr, fq * 8), boff = lds_byte(wc * 32 + fr, fq * 8);
#define PG8_SA(b, h) (((b) * 2 + (h)) * HTB)
#define PG8_SB(b, h) ((4 + (b) * 2 + (h)) * HTB)
#define PG8_STAGE(bufoff, gbase, voff) do { _Pragma("unroll") for (int _i = 0; _i < 2; ++_i) \
    __builtin_amdgcn_global_load_lds((const unsigned*)((const char*)(gbase) + (voff)[_i]), (LAS unsigned*)(lds + (bufoff) + ldsw + _i * 8192), 16, 0, 0); } while (0)
#define PG8_LDA(dst, b, h) do { _Pragma("unroll") for (int m = 0; m < 4; ++m) _Pragma("unroll") for (int k = 0; k < 2; ++k) dst[m][k] = *(const LAS bf16x8*)(lds + PG8_SA(b, h) + aoff + m * 2048 + k * 1024); } while (0)
#define PG8_LDB(dst, b, h) do { _Pragma("unroll") for (int n = 0; n < 2; ++n) _Pragma("unroll") for (int k = 0; k < 2; ++k) dst[n][k] = *(const LAS bf16x8*)(lds + PG8_SB(b, h) + boff + n * 2048 + k * 1024); } while (0)
#define PG8_MMA(ai, bj, At, Bt) do { __builtin_amdgcn_s_setprio(1); _Pragma("unroll") for (int m = 0; m < 4; ++m) _Pragma("unroll") for (int n = 0; n < 2; ++n) _Pragma("unroll") for (int k = 0; k < 2; ++k) \
    acc[ai][bj][m][n] = __builtin_amdgcn_mfma_f32_16x16x32_bf16(Bt[n][k], At[m][k], acc[ai][bj][m][n], 0, 0, 0); __builtin_amdgcn_s_setprio(0); } while (0)
#define PG8_WAIT_V(n) asm volatile("s_waitcnt vmcnt(" #n ")" ::: "memory")
#define PG8_WAIT_L(n) asm volatile("s_waitcnt lgkmcnt(" #n ")" ::: "memory")
#define PG8_BAR __builtin_amdgcn_s_barrier()
#define PG8_SCHED __builtin_amdgcn_sched_barrier(0)
  Unit cur, nxt; int ui = 0;
  if (!S.next(0, cur)) return;
  f32x4 acc[2][2][4][2];
#pragma unroll
  for (int a = 0; a < 2; ++a)
#pragma unroll
    for (int b = 0; b < 2; ++b)
#pragma unroll
      for (int m = 0; m < 4; ++m)
#pragma unroll
        for (int n = 0; n < 2; ++n) acc[a][b][m][n] = (f32x4){0.f, 0.f, 0.f, 0.f};
  bf16x8 At[4][2], B0[2][2], B1[2][2];
  const char* cA = (const char*)g.A + (size_t)cur.pm * tstepA; const char* cB = (const char*)g.Bt + (size_t)cur.pn * tstepB;
  PG8_STAGE(PG8_SB(0, 0), cB, voffB); PG8_STAGE(PG8_SA(0, 0), cA, voffA); PG8_STAGE(PG8_SB(0, 1), cB + hstepB, voffB); PG8_STAGE(PG8_SA(0, 1), cA + hstepA, voffA);
  if (wr == 1) PG8_BAR;
  PG8_WAIT_V(4); PG8_BAR;
  PG8_STAGE(PG8_SB(1, 0), cB + kstep, voffB); PG8_STAGE(PG8_SA(1, 0), cA + kstep, voffA); PG8_STAGE(PG8_SB(1, 1), cB + hstepB + kstep, voffB);
  PG8_WAIT_V(6); PG8_BAR;
  for (;;) {
    const bool has_next = S.next(ui + 1, nxt);
    const char* nA = has_next ? (const char*)g.A + (size_t)nxt.pm * tstepA : cA; const char* nB = has_next ? (const char*)g.Bt + (size_t)nxt.pn * tstepB : cB;
    for (int t = 0; t < nt; t += 2) {
      const bool last = (t == nt - 2);
      const char* a1 = cA + (size_t)(t + 1) * kstep;
      const char* a2 = last ? nA : cA + (size_t)(t + 2) * kstep; const char* b2 = last ? nB : cB + (size_t)(t + 2) * kstep;
      const char* a3 = a2 + kstep; const char* b3 = b2 + kstep;
      PG8_LDB(B0, 0, 0); PG8_SCHED; PG8_LDA(At, 0, 0); PG8_STAGE(PG8_SA(1, 1), a1 + hstepA, voffA);
      PG8_WAIT_L(8); PG8_BAR; PG8_WAIT_L(0); PG8_MMA(0, 0, At, B0); PG8_BAR; PG8_SCHED;
      PG8_LDB(B1, 0, 1); PG8_STAGE(PG8_SB(0, 0), b2, voffB);
      PG8_BAR; PG8_WAIT_L(0); PG8_MMA(0, 1, At, B1); PG8_BAR;
      PG8_LDA(At, 0, 1); PG8_STAGE(PG8_SA(0, 0), a2, voffA);
      PG8_BAR; PG8_WAIT_L(0); PG8_MMA(1, 0, At, B0); PG8_BAR; PG8_SCHED;
      PG8_STAGE(PG8_SB(0, 1), b2 + hstepB, voffB);
      PG8_WAIT_V(6); PG8_BAR; PG8_MMA(1, 1, At, B1); PG8_BAR;
      PG8_LDB(B0, 1, 0); PG8_SCHED; PG8_LDA(At, 1, 0); PG8_STAGE(PG8_SA(0, 1), a2 + hstepA, voffA);
      PG8_WAIT_L(8); PG8_BAR; PG8_WAIT_L(0); PG8_MMA(0, 0, At, B0); PG8_BAR; PG8_SCHED;
      PG8_LDB(B1, 1, 1); PG8_STAGE(PG8_SB(1, 0), b3, voffB);
      PG8_BAR; PG8_WAIT_L(0); PG8_MMA(0, 1, At, B1); PG8_BAR;
      PG8_LDA(At, 1, 1); PG8_STAGE(PG8_SA(1, 0), a3, voffA);
      PG8_BAR; PG8_WAIT_L(0); PG8_MMA(1, 0, At, B0); PG8_BAR; PG8_SCHED;
      PG8_STAGE(PG8_SB(1, 1), b3 + hstepB, voffB);
      PG8_WAIT_V(6); PG8_BAR; PG8_MMA(1, 1, At, B1); PG8_BAR;
    }
    E(acc, cur, wr, wc, fr, fq);
    if (!has_next) break;
#pragma unroll
    for (int a = 0; a < 2; ++a)
#pragma unroll
      for (int b = 0; b < 2; ++b)
#pragma unroll
        for (int m = 0; m < 4; ++m)
#pragma unroll
          for (int n = 0; n < 2; ++n) acc[a][b][m][n] = (f32x4){0.f, 0.f, 0.f, 0.f};
    cur = nxt; cA = nA; cB = nB; ++ui;
  }
  PG8_WAIT_V(0);
  if (wr == 0) PG8_BAR;
  PG8_BAR;
#undef PG8_SA
#undef PG8_SB
#undef PG8_STAGE
#undef PG8_LDA
#undef PG8_LDB
#undef PG8_MMA
#undef PG8_WAIT_V
#undef PG8_WAIT_L
#undef PG8_BAR
#undef PG8_SCHED
}
}
using pg8::Unit;
typedef f32x4 AccT[2][2][4][2];

DI u32x4 pack8(const f32x4& a, const f32x4& b) { u32x4 w; w.x = pk2(a[0], a[1]); w.y = pk2(a[2], a[3]); w.z = pk2(b[0], b[1]); w.w = pk2(b[2], b[3]); return w; }

struct EpiL0Main {
  static constexpr bool PERM = true;
  u16 *Q, *K, *P, *G; const float* rope; unsigned* kpart;
  DI void operator()(const AccT& acc, const Unit& u, int wr, int wc, int fr, int fq) const {
    const int pn = u.pn, row0 = u.pm * 256 + wr * 64 + fr;
    if (pn < 8) {
      const bool isq = pn < 4;
      const float sc = isq ? 0.125f * 1.4426950408889634f : 1.f;
      const int half = wc & 1, hi = fq >> 1, jj0 = 8 * (fq & 1), px = ((fq * 16 + fr) ^ 32) * 4;
      float nmax[2] = {0.f, 0.f};
#pragma unroll
      for (int ai = 0; ai < 2; ++ai)
#pragma unroll
        for (int m = 0; m < 4; ++m) {
          const int row = row0 + ai * 128 + m * 16, t = row & 2047, b = row >> 11;
          const int pos = half ? (t & 63) : (t >> 6);
          const f32x4 c0 = *(const f32x4*)(rope + pos * 16 + jj0), c1 = *(const f32x4*)(rope + pos * 16 + jj0 + 4);
          const f32x4 s0 = *(const f32x4*)(rope + 1024 + pos * 16 + jj0), s1 = *(const f32x4*)(rope + 1024 + pos * 16 + jj0 + 4);
#pragma unroll
          for (int bj = 0; bj < 2; ++bj) {
            f32x4 v0 = acc[ai][bj][m][0], v1 = acc[ai][bj][m][1], p0, p1;
#pragma unroll
            for (int e = 0; e < 4; ++e) { p0[e] = bperm(px, v0[e]); p1[e] = bperm(px, v1[e]); }
            f32x4 o0, o1;
            if (hi) { o0 = v0 * c0 + p0 * s0; o1 = v1 * c1 + p1 * s1; } else { o0 = v0 * c0 - p0 * s0; o1 = v1 * c1 - p1 * s1; }
            o0 *= sc; o1 *= sc;
            nmax[bj] = fmaxf(nmax[bj], (o0[0] * o0[0] + o0[1] * o0[1]) + (o0[2] * o0[2] + o0[3] * o0[3]) + (o1[0] * o1[0] + o1[1] * o1[1]) + (o1[2] * o1[2] + o1[3] * o1[3]));
            const int col = (pn & 3) * 256 + bj * 128 + wc * 32 + 8 * fq, sh = col >> 6, d = col & 63;
            u16* dst = isq ? Q + ((size_t)(b * 16 + sh) * SEQ + t) * 64 + d : K + ((size_t)(b * 16 + sh) * KALL + CTXL + t) * 64 + d;
            *(u32x4*)dst = pack8(o0, o1);
          }
        }
      if (!isq) {
        const int b = (u.pm * 256) >> 11;
#pragma unroll
        for (int bj = 0; bj < 2; ++bj) { const int sh = ((pn & 3) * 256 + bj * 128 + wc * 32) >> 6;
          atomicMax(kpart + (b * 16 + sh) * 8 + (wc & 1) * 4 + fq, __float_as_uint(nmax[bj] * 1.02f)); }
      }
    } else if (pn < 12) {
#pragma unroll
      for (int ai = 0; ai < 2; ++ai)
#pragma unroll
        for (int m = 0; m < 4; ++m) {
          const int row = row0 + ai * 128 + m * 16;
#pragma unroll
          for (int bj = 0; bj < 2; ++bj) {
            const int col = (pn - 8) * 256 + bj * 128 + wc * 32 + 8 * fq;
            *(u32x4*)(P + (size_t)row * 1024 + col) = pack8(acc[ai][bj][m][0], acc[ai][bj][m][1]);
          }
        }
    } else {
#pragma unroll
      for (int ai = 0; ai < 2; ++ai)
#pragma unroll
        for (int m = 0; m < 4; ++m) {
          const int row = row0 + ai * 128 + m * 16;
#pragma unroll
          for (int bj = 0; bj < 2; ++bj) {
            const int col = (pn - 12) * 256 + bj * 128 + wc * 32 + 8 * fq;
            f32x4 v0 = acc[ai][bj][m][0], v1 = acc[ai][bj][m][1];
#pragma unroll
            for (int e = 0; e < 4; ++e) { v0[e] = silu_f(v0[e]); v1[e] = silu_f(v1[e]); }
            *(u32x4*)(G + (size_t)row * 2048 + col) = pack8(v0, v1);
          }
        }
    }
  }
};
struct EpiVt {
  static constexpr bool PERM = true;
  u16* Vt; int shift, toff;
  DI void operator()(const AccT& acc, const Unit& u, int wr, int wc, int fr, int fq) const {
    const int f0 = u.pm * 256 + wr * 64 + fr;
#pragma unroll
    for (int ai = 0; ai < 2; ++ai)
#pragma unroll
      for (int m = 0; m < 4; ++m) {
        const int f = f0 + ai * 128 + m * 16;
#pragma unroll
        for (int bj = 0; bj < 2; ++bj) {
          const int tok = u.pn * 256 + bj * 128 + wc * 32 + 8 * fq, b = tok >> shift, t = tok & ((1 << shift) - 1);
          *(u32x4*)(Vt + ((size_t)(b * 8 + (f >> 7)) * 128 + (f & 127)) * KALL + toff + t) = pack8(acc[ai][bj][m][0], acc[ai][bj][m][1]);
        }
      }
  }
};
struct EpiCtxK {
  static constexpr bool PERM = true;
  u16* K; unsigned* kpart;
  DI void operator()(const AccT& acc, const Unit& u, int wr, int wc, int fr, int fq) const {
    const int row0 = u.pm * 256 + wr * 64 + fr;
    float nmax[2] = {0.f, 0.f};
#pragma unroll
    for (int ai = 0; ai < 2; ++ai)
#pragma unroll
      for (int m = 0; m < 4; ++m) {
        const int row = row0 + ai * 128 + m * 16, b = row >> 8, t = row & 255;
#pragma unroll
        for (int bj = 0; bj < 2; ++bj) {
          const int col = u.pn * 256 + bj * 128 + wc * 32 + 8 * fq, sh = col >> 6, d = col & 63;
          const f32x4 o0 = acc[ai][bj][m][0], o1 = acc[ai][bj][m][1];
          nmax[bj] = fmaxf(nmax[bj], (o0[0] * o0[0] + o0[1] * o0[1]) + (o0[2] * o0[2] + o0[3] * o0[3]) + (o1[0] * o1[0] + o1[1] * o1[1]) + (o1[2] * o1[2] + o1[3] * o1[3]));
          *(u32x4*)(K + ((size_t)(b * 16 + sh) * KALL + t) * 64 + d) = pack8(o0, o1);
        }
      }
    const int b = u.pm;
#pragma unroll
    for (int bj = 0; bj < 2; ++bj) { const int sh = (u.pn * 256 + bj * 128 + wc * 32) >> 6;
      atomicMax(kpart + (b * 16 + sh) * 8 + (wc & 1) * 4 + fq, __float_as_uint(nmax[bj] * 1.02f)); }
  }
};
struct EpiPool {
  static constexpr bool PERM = true;
  u16* G; const float* pscale; int grp;
  DI void operator()(const AccT& acc, const Unit& u, int wr, int wc, int fr, int fq) const {
    const int row0 = u.pm * 256 + wr * 64 + fr;
#pragma unroll
    for (int bj = 0; bj < 2; ++bj) {
      const int col = grp * 256 + bj * 128 + wc * 32 + 8 * fq;
      const f32x4 ps0 = *(const f32x4*)(pscale + col), ps1 = *(const f32x4*)(pscale + col + 4);
#pragma unroll
      for (int ai = 0; ai < 2; ++ai)
#pragma unroll
        for (int m = 0; m < 4; ++m) {
          const int row = row0 + ai * 128 + m * 16;
          u16* p = G + (size_t)row * 2048 + 1024 + col;
          const u32x4 gv = *(const u32x4*)p;
          f32x4 g0 = {bflo(gv.x), bfhi(gv.x), bflo(gv.y), bfhi(gv.y)}, g1 = {bflo(gv.z), bfhi(gv.z), bflo(gv.w), bfhi(gv.w)};
          *(u32x4*)p = pack8(acc[ai][bj][m][0] * ps0 * g0, acc[ai][bj][m][1] * ps1 * g1);
        }
    }
  }
};
struct EpiResid {
  static constexpr bool PERM = false;
  const float* src; float* dst; const float* gate;
  DI void operator()(const AccT& acc, const Unit& u, int wr, int wc, int fr, int fq) const {
    const int row0 = u.pm * 256 + wr * 64 + fr, col0 = u.pn * 256 + wc * 32 + 4 * fq, b = (u.pm * 256) >> 11;
#pragma unroll
    for (int bj = 0; bj < 2; ++bj)
#pragma unroll
      for (int n = 0; n < 2; ++n) {
        const int col = col0 + bj * 128 + n * 16;
        const f32x4 gt = *(const f32x4*)(gate + b * 1024 + col);
#pragma unroll
        for (int ai = 0; ai < 2; ++ai)
#pragma unroll
          for (int m = 0; m < 4; ++m) {
            const size_t o = (size_t)(row0 + ai * 128 + m * 16) * 1024 + col;
            *(f32x4*)(dst + o) = *(const f32x4*)(src + o) + gt * acc[ai][bj][m][n];
          }
      }
  }
};
struct EpiPlain {
  static constexpr bool PERM = true;
  u16* O; int ldc;
  DI void operator()(const AccT& acc, const Unit& u, int wr, int wc, int fr, int fq) const {
    const int row0 = u.pm * 256 + wr * 64 + fr, col0 = u.pn * 256 + wc * 32 + 8 * fq;
#pragma unroll
    for (int ai = 0; ai < 2; ++ai)
#pragma unroll
      for (int m = 0; m < 4; ++m)
#pragma unroll
        for (int bj = 0; bj < 2; ++bj)
          *(u32x4*)(O + (size_t)(row0 + ai * 128 + m * 16) * ldc + col0 + bj * 128) = pack8(acc[ai][bj][m][0], acc[ai][bj][m][1]);
  }
};

template <class Epi>
DI void run_gemm(int wv, LAS unsigned char* lds, const u16* A, int lda, const u16* Bt, int ldb, int M, int N, int K, int coff, const Epi& E) {
  asm volatile("" : "+s"(K));
  pg8::Gemm g; g.A = A; g.Bt = Bt; g.M = M; g.N = N; g.K = K; g.lda = lda; g.ldb = ldb;
  pg8::StaticOrder S; S.init(M, N, (int)gridDim.x, (int)((blockIdx.x + coff) % gridDim.x));
  pg8::gemm_phase<Epi>(lds, g, S, E, wv);
  __syncthreads();
}

DI void tr_item(const float* W, int K, int N, u16* WT, int k0, int n0, int drow0, LAS float* scr, int lane) {
#pragma unroll
  for (int i = 0; i < 32; ++i) { const int kk = 2 * i + (lane >> 5); scr[kk * 33 + (lane & 31)] = __builtin_nontemporal_load(W + (size_t)(k0 + kk) * N + n0 + (lane & 31)); }
  __builtin_amdgcn_wave_barrier();
  const int c = lane & 7;
#pragma unroll
  for (int j = 0; j < 4; ++j) { const int n = (lane >> 3) + 8 * j; const LAS float* s = scr + (8 * c) * 33 + n;
    u32x4 o; o.x = pk2(s[0 * 33], s[1 * 33]); o.y = pk2(s[2 * 33], s[3 * 33]); o.z = pk2(s[4 * 33], s[5 * 33]); o.w = pk2(s[6 * 33], s[7 * 33]);
    *(u32x4*)(WT + (size_t)(drow0 + n) * K + k0 + 8 * c) = o; }
  __builtin_amdgcn_wave_barrier();
}

DI void phase0(const Params& p, LAS unsigned char* lds, int wv) {
  const int lane = lane_id(), wave = wv, tid = wv * 64 + lane, bid = blockIdx.x, G = gridDim.x;
  unsigned char* ws = p.ws;
  {
    LAS float* sc = (LAS float*)lds;
    for (int item = bid; item < 96; item += G) {
      const int l = item / 48, r2 = item % 48, ks = r2 / 6, cb = r2 % 6;
      __syncthreads();
      for (int i = tid; i < 17 * 128; i += 512) { const int rr = i >> 7, k = ks * 128 + (i & 127); const float cv = rr < 16 ? p.in[I_C][rr * 1024 + k] : p.in[I_CCTX][k]; sc[i] = silu_f(cv); }
      __syncthreads();
      const int j = cb * 512 + tid;
      float a[17];
#pragma unroll
      for (int rr = 0; rr < 17; ++rr) a[rr] = 0.f;
      const float* W = p.in[I_ADAW] + (size_t)l * 1024 * 3072 + (size_t)(ks * 128) * 3072 + j;
#pragma unroll 16
      for (int kk = 0; kk < 128; ++kk) { const float w = W[(size_t)kk * 3072];
#pragma unroll
        for (int rr = 0; rr < 17; ++rr) a[rr] += sc[rr * 128 + kk] * w; }
      float* o = (float*)(ws + WS_ADAP) + (size_t)((l * 8 + ks) * 17) * 3072 + j;
#pragma unroll
      for (int rr = 0; rr < 17; ++rr) o[(size_t)rr * 3072] = a[rr];
    }
    __syncthreads();
  }
  if (bid == G - 1) {
    float* rope = (float*)(ws + WS_ROPE);
    for (int i = tid; i < 1024; i += 512) { const int pos = i >> 4, jj = i & 15; const float inv = powf(10000.f, -(float)jj / 16.f), ang = (float)pos * inv; rope[i] = cosf(ang); rope[1024 + i] = sinf(ang); }
  }
  {
    LAS float* mw = (LAS float*)(lds + 71680);
    __syncthreads();
#pragma unroll
    for (int q = 0; q < 5; ++q) { const int i = tid + 512 * q; if (i < 2112) mw[i] = p.in[I_FW0][i]; }
#pragma unroll
    for (int q = 0; q < 8; ++q) { const int i = tid + 512 * q; mw[2112 + i] = p.in[I_FW1][i]; mw[6208 + i] = p.in[I_FW2][i]; }
    __syncthreads();
    for (int t = bid * 8 + wave; t < SEQ; t += G * 8) {
      const float tl = (float)t / 2047.f, w = 6.283185307179586f * (float)t / 2048.f;
      float zv = 0.f;
      if (lane == 0) zv = tl;
      else if (lane < 33) { const int i = (lane - 1) & 15; const float band = 1e-4f + (float)i * ((15.f - 1e-4f) / 15.f); zv = lane < 17 ? cosf(band * w) : -sinf(band * w); }
      float a = 0.f;
#pragma unroll
      for (int i = 0; i < 33; ++i) a += __uint_as_float(__builtin_amdgcn_readlane(__float_as_uint(zv), i)) * mw[i * 64 + lane];
      float h = sinf(p.in[I_FF0][lane] * (a + p.in[I_FB0][lane]));
      a = 0.f;
#pragma unroll
      for (int i = 0; i < 64; ++i) a += __uint_as_float(__builtin_amdgcn_readlane(__float_as_uint(h), i)) * mw[2112 + i * 64 + lane];
      h = sinf(p.in[I_FF1][lane] * (a + p.in[I_FB1][lane]));
      a = 0.f;
#pragma unroll
      for (int i = 0; i < 64; ++i) a += __uint_as_float(__builtin_amdgcn_readlane(__float_as_uint(h), i)) * mw[6208 + i * 64 + lane];
      h = sinf(p.in[I_FF2][lane] * (a + p.in[I_FB2][lane]));
      ((float*)(ws + WS_H3))[t * 64 + lane] = h;
    }
  }
  {
    u16* WPB = (u16*)(ws + WS_G);
    for (int i = bid * 512 + tid; i < 1024 * 256; i += G * 512) { const int k = i >> 8, c4 = i & 255;
      const f32x4 v = *(const f32x4*)(p.in[I_AWIN] + (size_t)k * 6144 + 3072 + c4 * 4);
      u32x2 w; w.x = pk2(v[0], v[1]); w.y = pk2(v[2], v[3]);
      *(u32x2*)(WPB + (size_t)k * 1024 + c4 * 4) = w; }
  }
  {
    LAS float* scr = (LAS float*)lds + wave * (64 * 33);
    constexpr int I_A = 16 * 192, I_AO = 32 * 32, I_P = 128, I_H = 16 * 256, I_HO = 32 * 32, NIT = I_A + I_AO + I_P + I_H + I_HO;
    for (int it = bid * 8 + wave; it < NIT; it += G * 8) {
      int r = it;
      if (r < I_A) { const int kb = r / 192, nb = r % 192, n0 = nb * 32; const int drow = n0 < 2048 ? n0 : (n0 < 3072 ? n0 + 3072 : n0 - 1024);
        tr_item(p.in[I_AWIN], 1024, 6144, (u16*)(ws + WS_WA), kb * 64, n0, drow, scr, lane); continue; } r -= I_A;
      if (r < I_AO) { const int kb = r / 32, nb = r % 32; tr_item(p.in[I_AWOUT], 2048, 1024, (u16*)(ws + WS_WAO), kb * 64, nb * 32, nb * 32, scr, lane); continue; } r -= I_AO;
      if (r < I_P) { const int g = r / 32, q = r % 32, kb = q / 8, nb = q % 8; tr_item(p.in[I_POOLW] + g * 65536, 256, 256, (u16*)(ws + WS_PW) + g * 65536, kb * 64, nb * 32, nb * 32, scr, lane); continue; } r -= I_P;
      if (r < I_H) { const int kb = r / 256, nb = r % 256, n0 = nb * 32; const int part = n0 >> 11, c = n0 & 2047; const int drow = (c >> 9) * 2048 + part * 512 + (c & 511);
        tr_item(p.in[I_HWIN], 1024, 8192, (u16*)(ws + WS_WH), kb * 64, n0, drow, scr, lane); continue; } r -= I_H;
      { const int kb = r / 32, nb = r % 32; tr_item(p.in[I_HWOUT], 2048, 1024, (u16*)(ws + WS_WHO), kb * 64, nb * 32, nb * 32, scr, lane); }
    }
  }
}

DI void mod_vectors(const Params& p, int wv, int l, int r, LAS float* gs, LAS float* sh, float* gate_out) {
  const float* adaP = (const float*)(p.ws + WS_ADAP);
  for (int j = OTID(wv); j < 1024; j += 512) {
    float s0 = p.in[I_ADAB][l * 3072 + j], s1 = p.in[I_ADAB][l * 3072 + 1024 + j], s2 = p.in[I_ADAB][l * 3072 + 2048 + j];
#pragma unroll
    for (int ks = 0; ks < 8; ++ks) { const float* a = adaP + (size_t)((l * 8 + ks) * 17 + r) * 3072 + j; s0 += a[0]; s1 += a[1024]; s2 += a[2048]; }
    sh[j] = s0; gs[j] = p.in[I_NORMG][l * 1024 + j] * (1.f + s1);
    if (gate_out) gate_out[j] = s2;
  }
}
DI void mod_row(const float* xrow, u16* orow, const LAS float* gs, const LAS float* sh, int lane) {
  f32x4 v[4]; float ss = 0.f;
#pragma unroll
  for (int j = 0; j < 4; ++j) { v[j] = *(const f32x4*)(xrow + 4 * lane + 256 * j); ss += (v[j][0] * v[j][0] + v[j][1] * v[j][1]) + (v[j][2] * v[j][2] + v[j][3] * v[j][3]); }
  const float rstd = rsqrtf(wave_sum(ss) * (1.f / 1024.f) + 1e-6f);
#pragma unroll
  for (int j = 0; j < 4; ++j) {
    const int c = 4 * lane + 256 * j;
    const f32x4 g4 = *(const LAS f32x4*)(gs + c), s4 = *(const LAS f32x4*)(sh + c);
    const f32x4 o = v[j] * rstd * g4 + s4;
    u32x2 w; w.x = pk2(o[0], o[1]); w.y = pk2(o[2], o[3]);
    *(u32x2*)(orow + c) = w;
  }
}

DI void phase1(const Params& p, LAS unsigned char* lds, int wv) {
  const int lane = lane_id(), wave = wv, tid = wv * 64 + lane, bid = blockIdx.x, G = gridDim.x;
  unsigned char* ws = p.ws;
  {
    const float* H3 = (const float*)(ws + WS_H3);
    const float* wout = p.in[I_FWOUT];
    u16* F = (u16*)(ws + WS_F);
    const float mind = -3.0701134573253945f, maxd = -15.350567286626973f;
    LAS float* Hs = (LAS float*)lds;
    LAS float* Wl = (LAS float*)(lds + 16384) + wave * 2048;
    for (int it = bid; it < 1024; it += G) {
      const int tb = it & 31, cs = it >> 5, t = tb * 64 + lane, colb = cs * 256 + wave * 32, dir = (colb >> 11) & 1, o = colb >> 12;
      __syncthreads();
#pragma unroll
      for (int q = 0; q < 2; ++q) { const int idx = tid + 512 * q, tt = idx >> 4, j4 = idx & 15;
        const f32x4 h4 = *(const f32x4*)(H3 + (size_t)(tb * 64 + tt) * 64 + j4 * 4);
        Hs[(4 * j4) * 64 + tt] = h4[0]; Hs[(4 * j4 + 1) * 64 + tt] = h4[1]; Hs[(4 * j4 + 2) * 64 + tt] = h4[2]; Hs[(4 * j4 + 3) * 64 + tt] = h4[3]; }
#pragma unroll
      for (int q = 0; q < 8; ++q) { const int j = q * 8 + (lane >> 3), c4 = lane & 7;
        *(LAS f32x4*)(Wl + j * 32 + c4 * 4) = *(const f32x4*)(wout + (size_t)j * 8192 + colb + c4 * 4); }
      __syncthreads();
      f32x4 acc[8];
#pragma unroll
      for (int c = 0; c < 8; ++c) acc[c] = (f32x4){0.f, 0.f, 0.f, 0.f};
#pragma unroll 4
      for (int j = 0; j < 64; ++j) {
        const float h = Hs[j * 64 + lane];
#pragma unroll
        for (int c = 0; c < 8; ++c) acc[c] += h * *(const LAS f32x4*)(Wl + j * 32 + c * 4);
      }
      const float tl = (float)t / 2047.f;
#pragma unroll
      for (int c = 0; c < 8; ++c)
#pragma unroll
        for (int e = 0; e < 4; ++e) {
          const int cch = (colb + c * 4 + e) & 2047;
          const float delta = fabsf(mind + (float)cch * ((maxd - mind) / 2047.f));
          const float val = acc[c][e] * expf(-tl * delta);
          u16* Fr = F + (size_t)(cch * 2 + o) * 4096;
          const int idx = dir == 0 ? 2047 - t : (t > 0 ? 2047 + t : 4095);
          Fr[idx] = (dir == 1 && t == 0) ? (u16)0 : (u16)(pk2(val, 0.f) & 0xffffu);
        }
    }
  }
  __syncthreads();
#pragma unroll 1
  for (int g = 0; g < 4; ++g) { EpiPlain E; E.O = (u16*)(ws + WS_WA) + (size_t)(2048 + g * 256) * 1024; E.ldc = 1024;
    run_gemm(wv, lds, (const u16*)(ws + WS_PW) + g * 65536, 256, (const u16*)(ws + WS_G) + g * 256, 1024, 256, 1024, 256, 256 - 4 * g, E); }
  {
    LAS float* gs = (LAS float*)lds; LAS float* sh = gs + 1024; LAS float* gsc = sh + 1024; LAS float* shc = gsc + 1024;
    const int b = bid >> 4;
    float* gate = (float*)(ws + WS_GATE);
    __syncthreads();
    mod_vectors(p, wv, 0, b, gs, sh, (bid & 15) == 0 ? gate + b * 1024 : nullptr);
    mod_vectors(p, wv, 0, 16, gsc, shc, nullptr);
    __syncthreads();
    for (int i = 0; i < 16; ++i) { const int row = bid * 128 + wave * 16 + i; mod_row(p.in[I_X] + (size_t)row * 1024, (u16*)(ws + WS_H) + (size_t)row * 1024, gs, sh, lane); }
    for (int i = 0; i < 2; ++i) { const int row = bid * 16 + wave * 2 + i; mod_row(p.in[I_CTX] + (size_t)row * 1024, (u16*)(ws + WS_HC) + (size_t)row * 1024, gsc, shc, lane); }
    __syncthreads();
  }
}

DI void pool_means(const Params& p, int wv) {
  const u16* P = (const u16*)((unsigned char*)p.out + 64 * MB);
  u16* G = (u16*)(p.ws + WS_G); const float* pscale = p.in[I_POOLS];
  for (int gid = blockIdx.x * 512 + OTID(wv); gid < NB * 64 * 128; gid += gridDim.x * 512) {
    const int ch = gid & 127, r = (gid >> 7) & 63, b = gid >> 13, gi = ch >> 5, hw = 1 << gi;
    const u16* base = P + (size_t)b * SEQ * 1024 + ch * 8;
    const int t0 = r * 32;
    const f32x4 ps0 = *(const f32x4*)(pscale + ch * 8), ps1 = *(const f32x4*)(pscale + ch * 8 + 4);
    float s[8];
#pragma unroll
    for (int e = 0; e < 8; ++e) s[e] = 0.f;
    for (int q = t0 - hw; q < t0 + hw; ++q) if (q >= 0 && q < SEQ) { const u32x4 v = *(const u32x4*)(base + (size_t)q * 1024);
      s[0] += bflo(v.x); s[1] += bfhi(v.x); s[2] += bflo(v.y); s[3] += bfhi(v.y); s[4] += bflo(v.z); s[5] += bfhi(v.z); s[6] += bflo(v.w); s[7] += bfhi(v.w); }
#pragma unroll 4
    for (int t = t0; t < t0 + 32; ++t) {
      const int lo = max(t - hw, 0), hi = min(t + hw, SEQ);
      const float inv = 1.f / (float)(hi - lo);
      const u32x4 c = *(const u32x4*)(base + (size_t)t * 1024);
      u16* gp = G + ((size_t)b * SEQ + t) * 2048 + 1024 + ch * 8;
      const u32x4 gv = *(const u32x4*)gp;
      u32x4 o;
      o.x = pk2((s[0] * inv - bflo(c.x)) * ps0[0] * bflo(gv.x), (s[1] * inv - bfhi(c.x)) * ps0[1] * bfhi(gv.x)); o.y = pk2((s[2] * inv - bflo(c.y)) * ps0[2] * bflo(gv.y), (s[3] * inv - bfhi(c.y)) * ps0[3] * bfhi(gv.y));
      o.z = pk2((s[4] * inv - bflo(c.z)) * ps1[0] * bflo(gv.z), (s[5] * inv - bfhi(c.z)) * ps1[1] * bfhi(gv.z)); o.w = pk2((s[6] * inv - bflo(c.w)) * ps1[2] * bflo(gv.w), (s[7] * inv - bfhi(c.w)) * ps1[3] * bfhi(gv.w));
      *(u32x4*)gp = o;
      if (t + hw < SEQ) { const u32x4 v = *(const u32x4*)(base + (size_t)(t + hw) * 1024);
        s[0] += bflo(v.x); s[1] += bfhi(v.x); s[2] += bflo(v.y); s[3] += bfhi(v.y); s[4] += bflo(v.z); s[5] += bfhi(v.z); s[6] += bflo(v.w); s[7] += bfhi(v.w); }
      if (t - hw >= 0) { const u32x4 v = *(const u32x4*)(base + (size_t)(t - hw) * 1024);
        s[0] -= bflo(v.x); s[1] -= bfhi(v.x); s[2] -= bflo(v.y); s[3] -= bfhi(v.y); s[4] -= bflo(v.z); s[5] -= bfhi(v.z); s[6] -= bflo(v.w); s[7] -= bfhi(v.w); }
    }
  }
}

constexpr int AT_KSTR = 144, AT_VSTR = 136, AT_K1 = 9216, AT_V = 18432, AT_STAGE = 35840;
#define MFMA32(a, b, c) __builtin_amdgcn_mfma_f32_32x32x16_bf16((a), (b), (c), 0, 0, 0)
template <bool ZS> DI void att_tile(const LAS unsigned char* st, int sub, int ql, int hh, const bf16x8 (&qf)[4], float nshift, f32x16 (&O)[4], float& l) {
  const LAS unsigned char* kb_ = st + sub * AT_K1 + ql * AT_KSTR + 16 * hh;
  const LAS unsigned char* vb_ = st + AT_V + ql * AT_VSTR + 8 * hh;
  f32x16 S[2];
#pragma unroll
  for (int kb = 0; kb < 2; ++kb) {
#pragma unroll
    for (int r = 0; r < 16; ++r) S[kb][r] = ZS ? 0.f : nshift;
#pragma unroll
    for (int ks = 0; ks < 4; ++ks) { const bf16x8 kf = *(const LAS bf16x8*)(kb_ + kb * (32 * AT_KSTR) + ks * 32); S[kb] = MFMA32(kf, qf[ks], S[kb]); }
  }
  float ps = 0.f;
#pragma unroll
  for (int kb = 0; kb < 2; ++kb)
#pragma unroll
    for (int r = 0; r < 16; ++r) { const float e = __builtin_amdgcn_exp2f(S[kb][r]); S[kb][r] = e; ps += e; }
  l += ps;
#pragma unroll
  for (int kb = 0; kb < 2; ++kb)
#pragma unroll
    for (int s2 = 0; s2 < 2; ++s2) {
      u32x4 pw; pw.x = pk2(S[kb][8 * s2], S[kb][8 * s2 + 1]); pw.y = pk2(S[kb][8 * s2 + 2], S[kb][8 * s2 + 3]); pw.z = pk2(S[kb][8 * s2 + 4], S[kb][8 * s2 + 5]); pw.w = pk2(S[kb][8 * s2 + 6], S[kb][8 * s2 + 7]);
      const bf16x8 pf = __builtin_bit_cast(bf16x8, pw);
#pragma unroll
      for (int blk = 0; blk < 4; ++blk) {
        const LAS unsigned char* va = vb_ + blk * (32 * AT_VSTR) + (32 * kb + 16 * s2) * 2;
        const u32x2 lo = *(const LAS u32x2*)va, hi = *(const LAS u32x2*)(va + 16);
        const u32x4 vw = {lo.x, lo.y, hi.x, hi.y};
        O[blk] = MFMA32(__builtin_bit_cast(bf16x8, vw), pf, O[blk]);
      }
    }
}
DI void attention_phase(const Params& p, LAS unsigned char* lds, int wv, bool dry = false) {
  const int lane = lane_id(), tid = wv * 64 + lane;
  const int sub = wv >> 2, qg = wv & 3, ql = lane & 31, hh = lane >> 5, px = (lane ^ 32) * 4;
  const u16* Qb = (const u16*)p.out; const u16* Kb = (const u16*)(p.ws + WS_K); const u16* Vtb = (const u16*)(p.ws + WS_VT); u16* G = (u16*)(p.ws + WS_G);
  float lam;
  { const float a = p.in[I_LQ1][lane] * p.in[I_LK1][lane], b2 = p.in[I_LQ2][lane] * p.in[I_LK2][lane]; lam = expf(wave_sum(a)) - expf(wave_sum(b2)) + 0.2f; }
  const int krow = tid >> 3, kc = tid & 7;
  const unsigned koff = (unsigned)(krow * 128 + kc * 16), voff = (unsigned)(krow * (KALL * 2) + kc * 16);
  for (int it = 0; it < 8; ++it) {
    const int xj = blockIdx.x >> 3, bh = it * 16 + (blockIdx.x & 7) * 2 + (xj >> 4), qblk = xj & 15, b = bh >> 3, h = bh & 7;
    const char* kbase = (const char*)(Kb + (size_t)(b * 16 + 2 * h) * KALL * 64);
    const char* vbase = (const char*)(Vtb + (size_t)(b * 8 + h) * 128 * KALL);
    const int qrow = qblk * 128 + qg * 32 + ql;
    const u16* qp = Qb + ((size_t)(b * 16 + 2 * h + sub) * SEQ + qrow) * 64 + 8 * hh;
    bf16x8 qf[4];
#pragma unroll
    for (int ks = 0; ks < 4; ++ks) qf[ks] = *(const bf16x8*)(qp + 16 * ks);
    float nshift;
    { const float* kp = (const float*)(p.ws + WS_KPART) + (b * 16 + 2 * h + sub) * 8;
      float k2 = 0.f;
#pragma unroll
      for (int e = 0; e < 8; ++e) k2 += kp[e];
      float q2 = 0.f;
#pragma unroll
      for (int ks = 0; ks < 4; ++ks)
#pragma unroll
        for (int e = 0; e < 8; ++e) { const float qv = bf1((u16)qf[ks][e]); q2 += qv * qv; }
      q2 += bperm(px, q2);
      nshift = -sqrtf(q2 * k2); }
    const bool zs = __builtin_amdgcn_ballot_w64(nshift < -100.f) == 0ull;
    u32x4 ra[4];
#define AT_LOAD(kt_) do { const char* kb_ = kbase + (size_t)(kt_) * 8192; const char* vb_ = vbase + (size_t)(kt_) * 128; \
      ra[0] = *(const u32x4*)(kb_ + koff); ra[1] = *(const u32x4*)(kb_ + (size_t)KALL * 128 + koff); ra[2] = *(const u32x4*)(vb_ + voff); ra[3] = *(const u32x4*)(vb_ + (size_t)64 * KALL * 2 + voff); } while (0)
#define AT_WRITE(sn_) do { LAS unsigned char* s_ = (sn_); \
      *(LAS u32x4*)(s_ + krow * AT_KSTR + kc * 16) = ra[0]; *(LAS u32x4*)(s_ + AT_K1 + krow * AT_KSTR + kc * 16) = ra[1]; \
      *(LAS u32x2*)(s_ + AT_V + krow * AT_VSTR + kc * 16) = (u32x2){ra[2].x, ra[2].y}; *(LAS u32x2*)(s_ + AT_V + krow * AT_VSTR + kc * 16 + 8) = (u32x2){ra[2].z, ra[2].w}; \
      *(LAS u32x2*)(s_ + AT_V + (64 + krow) * AT_VSTR + kc * 16) = (u32x2){ra[3].x, ra[3].y}; *(LAS u32x2*)(s_ + AT_V + (64 + krow) * AT_VSTR + kc * 16 + 8) = (u32x2){ra[3].z, ra[3].w}; } while (0)
    AT_LOAD(0);
    __syncthreads();
    AT_WRITE(lds);
    __syncthreads();
    f32x16 O[4];
#pragma unroll
    for (int blk = 0; blk < 4; ++blk)
#pragma unroll
      for (int r = 0; r < 16; ++r) O[blk][r] = 0.f;
    float l = 0.f;
    if (zs) {
      for (int kt = 0; kt < KALL / 64; ++kt) {
        const bool more = kt + 1 < KALL / 64;
        if (more) AT_LOAD(kt + 1);
        att_tile<true>(lds + (kt & 1) * AT_STAGE, sub, ql, hh, qf, 0.f, O, l);
        if (more) AT_WRITE(lds + ((kt + 1) & 1) * AT_STAGE);
        __syncthreads();
      }
    } else {
      for (int kt = 0; kt < KALL / 64; ++kt) {
        const bool more = kt + 1 < KALL / 64;
        if (more) AT_LOAD(kt + 1);
        att_tile<false>(lds + (kt & 1) * AT_STAGE, sub, ql, hh, qf, nshift, O, l);
        if (more) AT_WRITE(lds + ((kt + 1) & 1) * AT_STAGE);
        __syncthreads();
      }
    }
#undef AT_LOAD
#undef AT_WRITE
    l += bperm(px, l);
    const float invl = 1.f / l;
    LAS float* X = (LAS float*)lds + qg * 4096;
    if (sub == 1) {
#pragma unroll
      for (int blk = 0; blk < 4; ++blk)
#pragma unroll
        for (int r = 0; r < 16; ++r) { const int dv = 32 * blk + (r & 3) + 8 * (r >> 2) + 4 * hh; X[dv * 32 + ql] = O[blk][r] * invl; }
    }
    __syncthreads();
    if (sub == 0) {
      float ss = 0.f;
#pragma unroll
      for (int blk = 0; blk < 4; ++blk)
#pragma unroll
        for (int r = 0; r < 16; ++r) { const int dv = 32 * blk + (r & 3) + 8 * (r >> 2) + 4 * hh; const float o = O[blk][r] * invl - lam * X[dv * 32 + ql]; O[blk][r] = o; ss += o * o; }
      ss += bperm(px, ss);
      const float rinv = rsqrtf(ss * (1.f / 128.f) + 1e-5f) * 0.8f;
      u16* grow = G + (size_t)(b * SEQ + qrow) * 2048 + h * 128;
#pragma unroll
      for (int blk = 0; blk < 4; ++blk)
#pragma unroll
        for (int g4 = 0; g4 < 4; ++g4) {
          const int dv = 32 * blk + 8 * g4 + 4 * hh;
          const f32x4 sg = *(const f32x4*)(p.in[I_SUBLN] + dv);
          const u32x2 gg = *(const u32x2*)(grow + dv);
          u32x2 o;
          o.x = pk2(O[blk][4 * g4] * rinv * sg[0] * bflo(gg.x), O[blk][4 * g4 + 1] * rinv * sg[1] * bfhi(gg.x));
          o.y = pk2(O[blk][4 * g4 + 2] * rinv * sg[2] * bflo(gg.y), O[blk][4 * g4 + 3] * rinv * sg[3] * bfhi(gg.y));
          if (dry) *(u32x2*)((u16*)(p.ws + WS_HC) + (size_t)(b * SEQ + qrow) * 128 + dv) = o; else *(u32x2*)(grow + dv) = o;
        }
    }
  }
  __syncthreads();
}

constexpr int CV_USTR = 4112;
constexpr int CV_FL = 66048;
constexpr int CV_FW = 2064;
DI void toeplitz_mma(f32x4 (&acc)[16], const LAS unsigned* FLo, const LAS unsigned char* U, int wv, int lane) {
  const int i = lane & 15, kq = lane >> 4;
  const int base = 2047 - 256 * wv - i + 8 * kq;
  const LAS unsigned* fl = FLo + (base & 1) * CV_FW + (base >> 1);
  const LAS unsigned char* ub = U + i * CV_USTR + kq * 16;
  bf16x8 win[16];
#pragma unroll
  for (int a = 0; a < 16; ++a) { const LAS unsigned* q = fl - 8 * a; u32x4 w = {q[0], q[1], q[2], q[3]}; win[a] = __builtin_bit_cast(bf16x8, w); }
  for (int so = 0; so < 8; ++so) {
#pragma unroll
    for (int si = 0; si < 8; ++si) {
      const int sg = so * 8 + si;
      const bf16x8 bfr = *(const LAS bf16x8*)(ub + 64 * sg);
      const LAS unsigned* q0 = fl + 16 * sg + 16; const LAS unsigned* q1 = fl + 16 * sg + 8;
      const u32x4 w0 = {q0[0], q0[1], q0[2], q0[3]}, w1 = {q1[0], q1[1], q1[2], q1[3]};
#pragma unroll
      for (int a = 0; a < 16; ++a) acc[a] = __builtin_amdgcn_mfma_f32_16x16x32_bf16(win[(a - 2 * si + 16) & 15], bfr, acc[a], 0, 0, 0);
      win[(-2 * si - 2 + 32) & 15] = __builtin_bit_cast(bf16x8, w0);
      win[(-2 * si - 1 + 32) & 15] = __builtin_bit_cast(bf16x8, w1);
    }
  }
}
DI f32x4 sconv4(const u16* row, int t, float w0, float w1, float w2, float cb) {
  const u32x2 c = *(const u32x2*)(row + t);
  const float xm = t > 0 ? bf1(row[t - 1]) : 0.f, xp = t + 4 < SEQ ? bf1(row[t + 4]) : 0.f;
  const float x0 = bflo(c.x), x1 = bfhi(c.x), x2 = bflo(c.y), x3 = bfhi(c.y);
  f32x4 r; r[0] = cb + w0 * xm + w1 * x0 + w2 * x1; r[1] = cb + w0 * x0 + w1 * x1 + w2 * x2; r[2] = cb + w0 * x1 + w1 * x2 + w2 * x3; r[3] = cb + w0 * x2 + w1 * x3 + w2 * xp;
  return r;
}
constexpr int CV_X = 65792;
constexpr int CV_FL1 = 131584;
DI void conv_load_row(const u16* row, const u16* grow, LAS unsigned char* dst, float w0, float w1, float w2, float cb, int tid) {
  u32x4 cur[8], gt[8]; unsigned hm[8], hp[8];
  const bool first = (tid & 255) == 0, last = (tid & 255) == 255;
  const u16* r = row + (size_t)tid * 8;
#pragma unroll
  for (int kj = 0; kj < 8; ++kj) {
    const u16* rk = r + (size_t)kj * 4096;
    cur[kj] = *(const u32x4*)rk;
    hm[kj] = first ? 0u : (unsigned)rk[-1];
    hp[kj] = last ? 0u : (unsigned)rk[8];
  }
  if (grow) {
    const u16* g = grow + (size_t)tid * 8;
#pragma unroll
    for (int kj = 0; kj < 8; ++kj) gt[kj] = *(const u32x4*)(g + (size_t)kj * 4096);
  }
#pragma unroll
  for (int kj = 0; kj < 8; ++kj) {
    const int k = tid + 512 * kj, b = k >> 8, t0 = (k & 255) * 8;
    const u32x4 c4 = cur[kj];
    float x[10]; x[0] = __uint_as_float(hm[kj] << 16); x[1] = bflo(c4.x); x[2] = bfhi(c4.x); x[3] = bflo(c4.y); x[4] = bfhi(c4.y); x[5] = bflo(c4.z); x[6] = bfhi(c4.z); x[7] = bflo(c4.w); x[8] = bfhi(c4.w); x[9] = __uint_as_float(hp[kj] << 16);
    float y[8];
#pragma unroll
    for (int e = 0; e < 8; ++e) y[e] = cb + w0 * x[e] + w1 * x[e + 1] + w2 * x[e + 2];
    if (grow) { const u32x4 g = gt[kj];
      y[0] *= silu_f(bflo(g.x)); y[1] *= silu_f(bfhi(g.x)); y[2] *= silu_f(bflo(g.y)); y[3] *= silu_f(bfhi(g.y)); y[4] *= silu_f(bflo(g.z)); y[5] *= silu_f(bfhi(g.z)); y[6] *= silu_f(bflo(g.w)); y[7] *= silu_f(bfhi(g.w)); }
    u32x4 o; o.x = pk2(y[0], y[1]); o.y = pk2(y[2], y[3]); o.z = pk2(y[4], y[5]); o.w = pk2(y[6], y[7]);
    *(LAS u32x4*)(dst + b * CV_USTR + t0 * 2) = o;
  }
}
DI void conv_load_filter(const u16* Fco, LAS unsigned* FLw, int tid) {
  const unsigned* Fg = (const unsigned*)Fco;
#pragma unroll
  for (int kj = 0; kj < 4; ++kj) { const int k = tid + 512 * kj; const unsigned w0 = Fg[k], w1 = (k + 1 < 2048) ? Fg[k + 1] : 0u;
    FLw[k] = w0; FLw[CV_FW + k] = (w0 >> 16) | (w1 << 16); }
  if (tid < 16) { FLw[2048 + tid] = 0u; FLw[CV_FW + 2048 + tid] = 0u; }
}
DI void conv_phase(const Params& p, LAS unsigned char* lds, int grp, int wv) {
  const int lane = lane_id(), tid = wv * 64 + lane;
  const u16* Ut = (const u16*)(p.ws + WS_UT);
  const u16* F = (const u16*)(p.ws + WS_F);
  u16* Zt = (u16*)(p.ws + WS_ZT);
  LAS unsigned* FLw = (LAS unsigned*)(lds + CV_FL1);
  const float* cw = p.in[I_CONVW]; const float* cbp = p.in[I_CONVB]; const float* fb = p.in[I_FBIAS];
  for (int ci = 0; ci < 2; ++ci) {
    const int cc = blockIdx.x * 2 + ci, c = grp * 512 + cc;
    __syncthreads();
    conv_load_filter(F + (size_t)(c * 2) * 4096, FLw, tid);
    conv_load_row(Ut + (size_t)cc * NTOK, nullptr, lds, cw[c], cw[6144 + c], cw[2 * 6144 + c], cbp[c], tid);
    conv_load_row(Ut + (size_t)(512 + cc) * NTOK, nullptr, lds + CV_X, cw[2048 + c], cw[6144 + 2048 + c], cw[2 * 6144 + 2048 + c], cbp[2048 + c], tid);
    __syncthreads();
    f32x4 acc[16];
#pragma unroll
    for (int a = 0; a < 16; ++a) acc[a] = (f32x4){0.f, 0.f, 0.f, 0.f};
    toeplitz_mma(acc, FLw, lds, wv, lane);
    {
      const int l2 = lane_id(), b = l2 & 15, kq = l2 >> 4;
      const float bias = fb[c];
#pragma unroll
      for (int a = 0; a < 16; ++a) {
        const int t = 256 * wv + 16 * a + 4 * kq;
        const u32x2 uu = *(const LAS u32x2*)(lds + b * CV_USTR + t * 2), xx = *(const LAS u32x2*)(lds + CV_X + b * CV_USTR + t * 2);
        const f32x4 u4 = {bflo(uu.x), bfhi(uu.x), bflo(uu.y), bfhi(uu.y)}, x4 = {bflo(xx.x), bfhi(xx.x), bflo(xx.y), bfhi(xx.y)};
        acc[a] = x4 * (acc[a] + bias * u4);
      }
    }
    __syncthreads();
    { const int l2 = lane_id(), b = l2 & 15, kq = l2 >> 4;
#pragma unroll
      for (int a = 0; a < 16; ++a) {
        const int t = 256 * wv + 16 * a + 4 * kq;
        u32x2 o; o.x = pk2(acc[a][0], acc[a][1]); o.y = pk2(acc[a][2], acc[a][3]);
        *(LAS u32x2*)(lds + b * CV_USTR + t * 2) = o;
        acc[a] = (f32x4){0.f, 0.f, 0.f, 0.f};
      } }
    { const int t2 = wv * 64 + lane_id();
      conv_load_filter(F + (size_t)(c * 2 + 1) * 4096, FLw, t2);
      conv_load_row(Ut + (size_t)(1024 + cc) * NTOK, Ut + (size_t)(1536 + cc) * NTOK, lds + CV_X, cw[4096 + c], cw[6144 + 4096 + c], cw[2 * 6144 + 4096 + c], cbp[4096 + c], t2); }
    __syncthreads();
    toeplitz_mma(acc, FLw, lds, wv, lane);
    {
      const int l2 = lane_id(), b = l2 & 15, kq = l2 >> 4;
      const float bias = fb[2048 + c];
#pragma unroll
      for (int a = 0; a < 16; ++a) {
        const int t = 256 * wv + 16 * a + 4 * kq;
        const u32x2 uu = *(const LAS u32x2*)(lds + b * CV_USTR + t * 2), xx = *(const LAS u32x2*)(lds + CV_X + b * CV_USTR + t * 2);
        const f32x4 z4 = {bflo(uu.x), bfhi(uu.x), bflo(uu.y), bfhi(uu.y)}, x4 = {bflo(xx.x), bfhi(xx.x), bflo(xx.y), bfhi(xx.y)};
        const f32x4 r = x4 * (acc[a] + bias * z4);
        u32x2 o; o.x = pk2(r[0], r[1]); o.y = pk2(r[2], r[3]);
        *(LAS u32x2*)(lds + CV_X + b * CV_USTR + t * 2) = o;
      }
    }
    __syncthreads();
    { const int t2 = wv * 64 + lane_id();
      u16* zrow = Zt + (size_t)c * NTOK;
#pragma unroll
      for (int kj = 0; kj < 8; ++kj) { const int k = t2 + 512 * kj, b = k >> 8, t0 = (k & 255) * 8;
        __builtin_nontemporal_store(*(const LAS u32x4*)(lds + CV_X + b * CV_USTR + t0 * 2), (u32x4*)(zrow + (size_t)k * 8)); } }
  }
  __syncthreads();
}

DI void transpose_phase(const Params& p, LAS unsigned char* lds, int wv) {
  const int lane = lane_id(), wave = wv;
  const u16* Zt = (const u16*)(p.ws + WS_ZT); u16* Z = (u16*)(p.ws + WS_Z);
  LAS unsigned char* scr = lds + wave * (64 * 144);
  for (int it = blockIdx.x * 8 + wave; it < 32 * 512; it += gridDim.x * 8) {
    const int cb = it & 31, tb = it >> 5, c0 = cb * 64, tok0 = tb * 64;
#pragma unroll
    for (int i = 0; i < 8; ++i) { const int cr = (lane >> 3) + 8 * i, tc = lane & 7;
      *(LAS u32x4*)(scr + cr * 144 + tc * 16) = __builtin_nontemporal_load((const u32x4*)(Zt + (size_t)(c0 + cr) * NTOK + tok0 + tc * 8)); }
    __builtin_amdgcn_wave_barrier();
#pragma unroll
    for (int i = 0; i < 8; ++i) { const int tk = (lane >> 3) + 8 * i, cc = lane & 7;
      const LAS u16* s = (const LAS u16*)(scr + (cc * 8) * 144 + tk * 2);
      u32x4 o;
      o.x = (unsigned)s[0] | ((unsigned)s[72] << 16); o.y = (unsigned)s[144] | ((unsigned)s[216] << 16);
      o.z = (unsigned)s[288] | ((unsigned)s[360] << 16); o.w = (unsigned)s[432] | ((unsigned)s[504] << 16);
      *(u32x4*)(Z + (size_t)(tok0 + tk) * 2048 + c0 + cc * 8) = o; }
    __builtin_amdgcn_wave_barrier();
  }
}

#define GS() do { ep += gridDim.x; gsync(bar, ep, wv); } while (0)
__global__ void __launch_bounds__(512, 2) fwd_megakernel(Params p) {
  extern __shared__ __attribute__((aligned(16))) unsigned char shm[];
  LAS unsigned char* lds = (LAS unsigned char*)shm;
  const int wv = __builtin_amdgcn_readfirstlane((int)threadIdx.x >> 6);
  cg::this_grid().sync();
  unsigned char* ws = p.ws;
  unsigned* bar = (unsigned*)ws; unsigned ep = 0;
  const int bid = blockIdx.x;
  u16* Qb = (u16*)p.out; u16* Pb = (u16*)((unsigned char*)p.out + 64 * MB);
  float* gate = (float*)(ws + WS_GATE);

  phase0(p, lds, wv);
  GS();
  phase1(p, lds, wv);
  GS();
  { EpiL0Main E; E.Q = Qb; E.K = (u16*)(ws + WS_K); E.P = Pb; E.G = (u16*)(ws + WS_G); E.rope = (const float*)(ws + WS_ROPE); E.kpart = (unsigned*)(ws + WS_KPART);
    run_gemm(wv, lds, (const u16*)(ws + WS_H), 1024, (const u16*)(ws + WS_WA), 1024, NTOK, 5120, 1024, 0, E);
#ifdef REP_G0
    run_gemm(wv, lds, (const u16*)(ws + WS_H), 1024, (const u16*)(ws + WS_WA), 1024, NTOK, 5120, 1024, 0, E);
#endif
  }
  { EpiVt E; E.Vt = (u16*)(ws + WS_VT); E.shift = 11; E.toff = CTXL;
    run_gemm(wv, lds, (const u16*)(ws + WS_WA) + (size_t)5120 * 1024, 1024, (const u16*)(ws + WS_H), 1024, 1024, NTOK, 1024, 0, E); }
  { EpiCtxK E; E.K = (u16*)(ws + WS_K); E.kpart = (unsigned*)(ws + WS_KPART);
    run_gemm(wv, lds, (const u16*)(ws + WS_HC), 1024, (const u16*)(ws + WS_WA) + (size_t)1024 * 1024, 1024, NCTX, 1024, 1024, 0, E); }
  { EpiVt E; E.Vt = (u16*)(ws + WS_VT); E.shift = 8; E.toff = 0;
    run_gemm(wv, lds, (const u16*)(ws + WS_WA) + (size_t)5120 * 1024, 1024, (const u16*)(ws + WS_HC), 1024, 1024, NCTX, 1024, 192, E); }
  GS();
  pool_means(p, wv);
#ifdef REP_ATT
  attention_phase(p, lds, wv, true);
#endif
  attention_phase(p, lds, wv);
  GS();
  { EpiResid E; E.src = p.in[I_X]; E.dst = p.out; E.gate = gate;
    run_gemm(wv, lds, (const u16*)(ws + WS_G), 2048, (const u16*)(ws + WS_WAO), 2048, NTOK, 1024, 2048, 0, E); }
  GS();
  {
    const int lane = lane_id(), wave = wv;
    LAS float* gs = (LAS float*)lds; LAS float* sh = gs + 1024;
    const int b = bid >> 4;
    mod_vectors(p, wv, 1, b, gs, sh, (bid & 15) == 0 ? gate + 16384 + b * 1024 : nullptr);
    __syncthreads();
    for (int i = 0; i < 16; ++i) { const int row = bid * 128 + wave * 16 + i; mod_row(p.out + (size_t)row * 1024, (u16*)(ws + WS_H) + (size_t)row * 1024, gs, sh, lane); }
    __syncthreads();
  }
  GS();
  for (int grp = 0; grp < 4; ++grp) {
    { EpiPlain E; E.O = (u16*)(ws + WS_UT); E.ldc = NTOK;
      run_gemm(wv, lds, (const u16*)(ws + WS_WH) + (size_t)grp * 2048 * 1024, 1024, (const u16*)(ws + WS_H), 1024, 2048, NTOK, 1024, 0, E);
#ifdef REP_G1
      run_gemm(wv, lds, (const u16*)(ws + WS_WH) + (size_t)grp * 2048 * 1024, 1024, (const u16*)(ws + WS_H), 1024, 2048, NTOK, 1024, 0, E);
#endif
    }
    GS();
    conv_phase(p, lds, grp, wv);
#ifdef REP_CONV
    conv_phase(p, lds, grp, wv);
#endif
    GS();
  }
  transpose_phase(p, lds, wv);
  GS();
  { EpiResid E; E.src = p.out; E.dst = p.out; E.gate = gate + 16384;
    run_gemm(wv, lds, (const u16*)(ws + WS_Z), 2048, (const u16*)(ws + WS_WHO), 2048, NTOK, 1024, 2048, 0, E); }
  GS();
  const int lane = lane_id(), wave = wv;
  for (int i = 0; i < 16; ++i) {
    const int row = bid * 128 + wave * 16 + i; float* xr = p.out + (size_t)row * 1024;
    f32x4 v[4]; float ss = 0.f;
#pragma unroll
    for (int j = 0; j < 4; ++j) { v[j] = __builtin_nontemporal_load((const f32x4*)(xr + 4 * lane + 256 * j)); ss += (v[j][0] * v[j][0] + v[j][1] * v[j][1]) + (v[j][2] * v[j][2] + v[j][3] * v[j][3]); }
    const float rstd = rsqrtf(wave_sum(ss) * (1.f / 1024.f) + 1e-6f);
#pragma unroll
    for (int j = 0; j < 4; ++j) { const f32x4 g4 = *(const f32x4*)(p.in[I_FINALG] + 4 * lane + 256 * j); __builtin_nontemporal_store(v[j] * rstd * g4, (f32x4*)(xr + 4 * lane + 256 * j)); }
  }
}

constexpr int LDS_BYTES = 148480;

extern "C" void kernel_launch(void* const* d_in, const int* in_sizes, int n_in, void* d_out, int out_size, void* d_ws, size_t ws_size, hipStream_t stream) {
  static int grid_blocks = 0;
  if (grid_blocks == 0) {
    if (n_in != 32 || out_size != NTOK * DM || ws_size < WS_END) { fprintf(stderr, "kernel_launch: unexpected shapes (n_in %d out %d ws %zu)\n", n_in, out_size, ws_size); grid_blocks = -1; return; }
    int dev = 0, cus = 0, per_cu = 0;
    hipGetDevice(&dev);
    hipDeviceGetAttribute(&cus, hipDeviceAttributeMultiprocessorCount, dev);
    if (hipFuncSetAttribute((const void*)fwd_megakernel, hipFuncAttributeMaxDynamicSharedMemorySize, LDS_BYTES) != hipSuccess) { fprintf(stderr, "hipFuncSetAttribute failed\n"); grid_blocks = -1; return; }
    hipOccupancyMaxActiveBlocksPerMultiprocessor(&per_cu, (const void*)fwd_megakernel, 512, LDS_BYTES);
    if (per_cu < 1 || cus < 256) { fprintf(stderr, "occupancy %d cus %d\n", per_cu, cus); grid_blocks = -1; return; }
    grid_blocks = 256;
  }
  if (grid_blocks < 0) return;
  if (hipMemsetAsync(d_ws, 0, WS_KPART + 8192, stream) != hipSuccess) { fprintf(stderr, "memset failed\n"); return; }
  Params p{};
  for (int i = 0; i < 32; ++i) p.in[i] = (const float*)d_in[i];
  p.out = (float*)d_out; p.ws = (unsigned char*)d_ws;
  void* args[] = {&p};
  hipError_t e = hipLaunchCooperativeKernel((void*)fwd_megakernel, dim3(grid_blocks), dim3(512), args, LDS_BYTES, stream);
  if (e != hipSuccess) fprintf(stderr, "cooperative launch failed: %s\n", hipGetErrorString(e));
}
```
